# Optimizing an MI355X kernel written in HIP

```python
import math
import jax, jax.numpy as jnp
from jax import lax
import numpy as np

D_MODEL = 1024
BATCH = 32
SEQ = 2048
DEPTH = 1
DEC_BATCH = 16
DEC_SEQ = 2048
PAST_LEN = 128

N_MEM = 256
DA_HEADS = 4
DA_DH = D_MODEL // 16
DA_DV = 2 * DA_DH
DA_W = DA_HEADS * DA_DV
CV_W = D_MODEL // 4
CONV_K = 3
MX_HEADS = 4
MX_DH = D_MODEL // 16
MX_W = MX_HEADS * MX_DH
MIX_W = DA_W + CV_W + MX_W
QK_W = 2 * DA_HEADS * DA_DH
SPLITS = (QK_W, QK_W, DA_W, DA_W, CV_W, CV_W, CV_W, CV_W, MX_W, MX_W)
IN_W = sum(SPLITS)
ROPE_THETA = 500000.0
ROT_DIM = DA_DH // 4
Q_BLOCK = 128
ALPHA = (2 * DEPTH) ** 0.25
BETA = (8 * DEPTH) ** -0.25
LN_EPS = 1e-5

kernel_name = "hybrid_diffattn_shortconv_memxattn_encoder"


def layer_norm(x, g, b):
    x32 = x.astype(jnp.float32)
    mu = jnp.mean(x32, axis=-1, keepdims=True)
    var = jnp.mean(jnp.square(x32 - mu), axis=-1, keepdims=True)
    y = (x32 - mu) * lax.rsqrt(var + LN_EPS) * g.astype(jnp.float32) + b.astype(jnp.float32)
    return y.astype(x.dtype)


def rms_norm(x, g):
    x32 = x.astype(jnp.float32)
    y = x32 * lax.rsqrt(jnp.mean(jnp.square(x32), axis=-1, keepdims=True) + LN_EPS) * g.astype(jnp.float32)
    return y


def rope_tables(seq_len):
    inv_freq = ROPE_THETA ** (-jnp.arange(0, ROT_DIM, 2, dtype=jnp.float32) / ROT_DIM)
    ang = jnp.arange(seq_len, dtype=jnp.float32)[:, None] * inv_freq[None, :]
    return jnp.cos(ang), jnp.sin(ang)


def partial_rope(x, cos, sin):
    xr = x[..., :ROT_DIM].astype(jnp.float32)
    xp = x[..., ROT_DIM:]
    half = ROT_DIM // 2
    x1, x2 = xr[..., :half], xr[..., half:]
    c = cos[None, :, None, None, :]
    s = sin[None, :, None, None, :]
    rot = jnp.concatenate([x1 * c - x2 * s, x2 * c + x1 * s], axis=-1).astype(x.dtype)
    return jnp.concatenate([rot, xp], axis=-1)


def diff_attention(q, k, v, lam, lam_init, subln_g):
    B, S = q.shape[0], q.shape[1]
    nb = S // Q_BLOCK
    scale = DA_DH ** -0.5
    qb = jnp.moveaxis(q.reshape(B, nb, Q_BLOCK, DA_HEADS, 2, DA_DH), 1, 0)

    def block(qblk):
        s = jnp.einsum('bqhcd,bkhcd->bhcqk', qblk, k).astype(jnp.float32) * scale
        p = jax.nn.softmax(s, axis=-1)
        a = p[:, :, 0] - lam * p[:, :, 1]
        return jnp.einsum('bhqk,bkhd->bqhd', a.astype(v.dtype), v)

    o = lax.map(block, qb)
    o = jnp.moveaxis(o, 0, 1).reshape(B, S, DA_HEADS, DA_DV)
    o = rms_norm(o, subln_g) * (1.0 - lam_init)
    return o.reshape(B, S, DA_W).astype(v.dtype)


def short_conv(u, w):
    C = u.shape[-1]
    return lax.conv_general_dilated(
        u, w[:, None, :].astype(u.dtype), window_strides=(1,),
        padding=((CONV_K // 2, CONV_K // 2),),
        dimension_numbers=('NWC', 'WIO', 'NWC'), feature_group_count=C)


def memory_attention(q, mem, w_mem_kv):
    B, S = q.shape[0], q.shape[1]
    kv = mem @ w_mem_kv
    k, v = jnp.split(kv, 2, axis=-1)
    qh = q.reshape(B, S, MX_HEADS, MX_DH)
    kh = k.reshape(B, N_MEM, MX_HEADS, MX_DH)
    vh = v.reshape(B, N_MEM, MX_HEADS, MX_DH)
    s = jnp.einsum('bqhd,bkhd->bhqk', qh, kh).astype(jnp.float32) * (MX_DH ** -0.5)
    p = jax.nn.softmax(s, axis=-1).astype(v.dtype)
    o = jnp.einsum('bhqk,bkhd->bqhd', p, vh)
    return o.reshape(B, S, MX_W)


def encoder_layer(x, mem, w_in, w_mem_kv, lam_q1, lam_k1, lam_q2, lam_k2, subln_g,
                  conv_w, w_o, ln_g, ln_b, cos, sin, layer_idx):
    B, S, _ = x.shape
    proj = x @ w_in
    idx = []
    acc = 0
    for w in SPLITS[:-1]:
        acc += w
        idx.append(acc)
    q_da, k_da, v_da, g_da, b_cv, c_cv, h_cv, g_cv, q_mx, g_mx = jnp.split(proj, idx, axis=-1)

    lam_init = 0.8 - 0.6 * math.exp(-0.3 * layer_idx)
    lam = (jnp.exp(jnp.sum(lam_q1.astype(jnp.float32) * lam_k1.astype(jnp.float32)))
           - jnp.exp(jnp.sum(lam_q2.astype(jnp.float32) * lam_k2.astype(jnp.float32))) + lam_init)
    q = partial_rope(q_da.reshape(B, S, DA_HEADS, 2, DA_DH), cos, sin)
    k = partial_rope(k_da.reshape(B, S, DA_HEADS, 2, DA_DH), cos, sin)
    v = v_da.reshape(B, S, DA_HEADS, DA_DV)
    o_da = diff_attention(q, k, v, lam, lam_init, subln_g) * jax.nn.silu(g_da)

    o_cv = b_cv * short_conv(c_cv * h_cv, conv_w) * jax.nn.silu(g_cv)

    o_mx = memory_attention(q_mx, mem, w_mem_kv) * jax.nn.silu(g_mx)

    out = jnp.concatenate([o_da, o_cv, o_mx], axis=-1) @ w_o
    return layer_norm(ALPHA * x + out, ln_g, ln_b)


def trunk(x, mem, in_ln_g, in_ln_b, w_in, w_mem_kv, lam_q1, lam_k1, lam_q2, lam_k2,
          subln_g, conv_w, w_o, ln_g, ln_b):
    cos, sin = rope_tables(x.shape[1])
    h = layer_norm(x, in_ln_g, in_ln_b)
    for l in range(DEPTH):
        h = encoder_layer(h, mem, w_in[l], w_mem_kv[l], lam_q1[l], lam_k1[l], lam_q2[l], lam_k2[l],
                          subln_g[l], conv_w[l], w_o[l], ln_g[l], ln_b[l], cos, sin, l)
    return h


def setup_inputs(seed: int = 0) -> dict:
    key = jax.random.key(seed)
    ks = jax.random.split(key, 17)
    f32 = jnp.float32
    v_start = 2 * QK_W
    col_scale = jnp.ones((IN_W,), f32).at[v_start:v_start + DA_W].set(BETA)
    w_in = jax.random.normal(ks[4], (DEPTH, D_MODEL, IN_W), f32) * (D_MODEL ** -0.5) * col_scale
    kv_scale = jnp.ones((2 * MX_W,), f32).at[MX_W:].set(BETA)
    w_mem_kv = jax.random.normal(ks[5], (DEPTH, D_MODEL, 2 * MX_W), f32) * (D_MODEL ** -0.5) * kv_scale
    return {
        "x_prompt": jax.random.normal(ks[0], (BATCH, SEQ, D_MODEL), f32),
        "x_sample": jax.random.normal(ks[1], (DEC_BATCH, DEC_SEQ, D_MODEL), f32),
        "mem_prompt": jax.random.normal(ks[2], (BATCH, N_MEM, D_MODEL), f32),
        "mem_sample": jax.random.normal(ks[3], (DEC_BATCH, N_MEM, D_MODEL), f32),
        "in_ln_g": 1.0 + 0.02 * jax.random.normal(ks[6], (D_MODEL,), f32),
        "in_ln_b": 0.02 * jax.random.normal(ks[7], (D_MODEL,), f32),
        "w_in": w_in,
        "w_mem_kv": w_mem_kv,
        "lam_q1": 0.1 * jax.random.normal(ks[8], (DEPTH, DA_DH), f32),
        "lam_k1": 0.1 * jax.random.normal(ks[9], (DEPTH, DA_DH), f32),
        "lam_q2": 0.1 * jax.random.normal(ks[10], (DEPTH, DA_DH), f32),
        "lam_k2": 0.1 * jax.random.normal(ks[11], (DEPTH, DA_DH), f32),
        "subln_g": 1.0 + 0.02 * jax.random.normal(ks[12], (DEPTH, DA_DV), f32),
        "conv_w": jax.random.normal(ks[13], (DEPTH, CONV_K, CV_W), f32) * (CONV_K ** -0.5),
        "w_o": jax.random.normal(ks[14], (DEPTH, MIX_W, D_MODEL), f32) * (MIX_W ** -0.5) * BETA,
        "ln_g": 1.0 + 0.02 * jax.random.normal(ks[15], (DEPTH, D_MODEL), f32),
        "ln_b": 0.02 * jax.random.normal(ks[16], (DEPTH, D_MODEL), f32),
    }


def reference(x_prompt, x_sample, mem_prompt, mem_sample, in_ln_g, in_ln_b, w_in, w_mem_kv,
              lam_q1, lam_k1, lam_q2, lam_k2, subln_g, conv_w, w_o, ln_g, ln_b):
    y_prompt = trunk(x_prompt, mem_prompt, in_ln_g, in_ln_b, w_in, w_mem_kv, lam_q1, lam_k1,
                     lam_q2, lam_k2, subln_g, conv_w, w_o, ln_g, ln_b)
    y_sample = trunk(x_sample, mem_sample, in_ln_g, in_ln_b, w_in, w_mem_kv, lam_q1, lam_k1,
                     lam_q2, lam_k2, subln_g, conv_w, w_o, ln_g, ln_b)
    return (y_prompt, y_sample)
```

```cpp
#include <hip/hip_runtime.h>
#include <hip/hip_cooperative_groups.h>
#include <cstdio>
#include <cstdint>
namespace cg = cooperative_groups;

constexpr int DM = 1024, SEQ = 2048, NSEQ = 48, NSEQ_P = 32;
constexpr int M = NSEQ * SEQ;
constexpr int M_P = NSEQ_P * SEQ;
constexpr int NMEM = 256, MM = NSEQ * NMEM, MM_P = NSEQ_P * NMEM;
constexpr int INW = 3584, KVW = 512;
constexpr int C_QDA = 0, C_KDA = 512, C_VDA = 1024, C_GDA = 1536, C_BCV = 2048, C_CCV = 2304, C_HCV = 2560, C_GCV = 2816, C_QMX = 3072, C_GMX = 3328;
constexpr float LN_EPS = 1e-5f;
constexpr float ALPHA = 1.189207115002721f;
constexpr float LAM_INIT = 0.2f;
constexpr float C2 = 0.125f * 1.4426950408889634f;

constexpr size_t MiB = 1u << 20;
constexpr size_t WS_WIN = 1 * MiB;
constexpr size_t WS_WKV = 8 * MiB;
constexpr size_t WS_WO = 9 * MiB;
constexpr size_t WS_ROPE = 11 * MiB;
constexpr size_t WS_STATS = 12 * MiB;
constexpr size_t WS_KV = 13 * MiB;
constexpr size_t WS_MEMB = 25 * MiB;
constexpr size_t WS_XN = 49 * MiB;
constexpr size_t WS_MIX = WS_XN;
constexpr size_t WS_PROJ = 241 * MiB;
constexpr size_t WS_END = 913 * MiB;

typedef unsigned short bf16_t;
typedef short bf16x8 __attribute__((ext_vector_type(8)));
typedef float f32x4 __attribute__((ext_vector_type(4)));
typedef float f32x16 __attribute__((ext_vector_type(16)));
typedef unsigned u32x4 __attribute__((ext_vector_type(4)));
typedef unsigned u32x2 __attribute__((ext_vector_type(2)));

__device__ __forceinline__ unsigned f2bf(float f) { unsigned u = __builtin_bit_cast(unsigned, f); return (u + 0x7fffu + ((u >> 16) & 1u)) >> 16; }
__device__ __forceinline__ unsigned pk2(float lo, float hi) { return f2bf(lo) | (f2bf(hi) << 16); }
__device__ __forceinline__ float bf2f(unsigned short h) { return __builtin_bit_cast(float, (unsigned)h << 16); }
__device__ __forceinline__ float bflo(unsigned w) { return __builtin_bit_cast(float, w << 16); }
__device__ __forceinline__ float bfhi(unsigned w) { return __builtin_bit_cast(float, w & 0xffff0000u); }
__device__ __forceinline__ float wave_sum(float v) {
#pragma unroll
    for (int o = 1; o < 64; o <<= 1) v += __shfl_xor(v, o);
    return v;
}
__device__ __forceinline__ float wave_max(float v) {
#pragma unroll
    for (int o = 1; o < 64; o <<= 1) v = fmaxf(v, __shfl_xor(v, o));
    return v;
}
__device__ __forceinline__ float silu(float g) { return g / (1.f + __expf(-g)); }

struct Args {
    const float* x_p; const float* x_s; const float* mem_p; const float* mem_s; const float* in_g; const float* in_b;
    const float* w_in; const float* w_kv; const float* lq1; const float* lk1; const float* lq2; const float* lk2;
    const float* subln; const float* conv_w; const float* w_o; const float* ln_g; const float* ln_b;
    float* out; unsigned char* ws;
};

__device__ __forceinline__ const float* xrow(const Args& a, int m) { return m < M_P ? a.x_p + (size_t)m * DM : a.x_s + (size_t)(m - M_P) * DM; }
__device__ __forceinline__ const float* memrow(const Args& a, int m) { return m < MM_P ? a.mem_p + (size_t)m * DM : a.mem_s + (size_t)(m - MM_P) * DM; }

__device__ __forceinline__ void transpose_item(const float* W, int K, int N, bf16_t* WT, float* scr, int item, int lane) {
    const int nblk = N / 32, kb = item / nblk, nb = item % nblk, k0 = 64 * kb, n0 = 32 * nb;
#pragma unroll 8
    for (int i = 0; i < 32; ++i) { const int kk = 2 * i + (lane >> 5); scr[kk * 33 + (lane & 31)] = W[(size_t)(k0 + kk) * N + n0 + (lane & 31)]; }
    __builtin_amdgcn_s_waitcnt(0xC07F); asm volatile("" ::: "memory");
    const int c = lane & 7;
#pragma unroll
    for (int j = 0; j < 4; ++j) { const int n = (lane >> 3) + 8 * j; const float* s = scr + (8 * c) * 33 + n;
        u32x4 o; o.x = pk2(s[0 * 33], s[1 * 33]); o.y = pk2(s[2 * 33], s[3 * 33]); o.z = pk2(s[4 * 33], s[5 * 33]); o.w = pk2(s[6 * 33], s[7 * 33]);
        *(u32x4*)(WT + (size_t)(n0 + n) * K + k0 + 8 * c) = o; }
    __builtin_amdgcn_s_waitcnt(0xC07F); asm volatile("" ::: "memory");
}

__device__ __forceinline__ void stage0(const Args& a, char* lds, int gw, int ngw, int wave, int lane) {
    unsigned char* ws = a.ws;
    float* scr = (float*)(lds + wave * 16384);
    constexpr int I_IN = (DM / 64) * (INW / 32), I_KV = (DM / 64) * (KVW / 32), I_O = (DM / 64) * (DM / 32);
    for (int it = gw; it < I_IN + I_KV + I_O; it += ngw) {
        int r = it;
        if (r < I_IN) { transpose_item(a.w_in, DM, INW, (bf16_t*)(ws + WS_WIN), scr, r, lane); continue; } r -= I_IN;
        if (r < I_KV) { transpose_item(a.w_kv, DM, KVW, (bf16_t*)(ws + WS_WKV), scr, r, lane); continue; } r -= I_KV;
        transpose_item(a.w_o, DM, DM, (bf16_t*)(ws + WS_WO), scr, r, lane);
    }
    {
        const double cf[8] = {0.5403023058681398, 0.9812558362840286, 0.9992929765482185, 0.9999734086383661, 0.9999990000001666, 0.9999999623939693, 0.9999999985857865, 0.999999999946817};
        const double sf[8] = {0.8414709848078965, 0.19270958398204202, 0.0375971677311151, 0.007292600096474083, 0.0014142130909686214, 0.00027424817223841217, 5.31829589443792e-05, 1.0313385377029628e-05};
        float* rope = (float*)(ws + WS_ROPE);
        for (int idx = gw * 64 + lane; idx < SEQ * 8; idx += ngw * 64) {
            const int t = idx >> 3, i = idx & 7;
            double bc = 1.0, bs = 0.0;
#pragma unroll
            for (int k = 0; k < 8; ++k) if (k == i) { bc = cf[k]; bs = sf[k]; }
            double c = 1.0, s = 0.0;
            for (int bit = 0; bit < 11; ++bit) {
                if ((t >> bit) & 1) { const double nc = c * bc - s * bs, ns = s * bc + c * bs; c = nc; s = ns; }
                const double n2c = bc * bc - bs * bs, n2s = 2.0 * bs * bc; bc = n2c; bs = n2s;
            }
            rope[t * 16 + i] = (float)c; rope[t * 16 + 8 + i] = (float)s;
        }
    }
    bf16_t* XN = (bf16_t*)(ws + WS_XN); float* stats = (float*)(ws + WS_STATS);
    f32x4 g4[4], b4[4];
#pragma unroll
    for (int j = 0; j < 4; ++j) { g4[j] = ((const f32x4*)a.in_g)[64 * j + lane]; b4[j] = ((const f32x4*)a.in_b)[64 * j + lane]; }
    for (int m = gw; m < M; m += ngw) {
        const f32x4* xr = (const f32x4*)xrow(a, m) + lane;
        f32x4 v[4]; float s = 0.f;
#pragma unroll
        for (int j = 0; j < 4; ++j) { v[j] = xr[64 * j]; s += (v[j].x + v[j].y) + (v[j].z + v[j].w); }
        const float mean = wave_sum(s) * (1.f / DM); float s2 = 0.f;
#pragma unroll
        for (int j = 0; j < 4; ++j) { v[j] = v[j] - mean; s2 += (v[j].x * v[j].x + v[j].y * v[j].y) + (v[j].z * v[j].z + v[j].w * v[j].w); }
        const float rstd = 1.f / sqrtf(wave_sum(s2) * (1.f / DM) + LN_EPS);
        u32x2* o8 = (u32x2*)(XN + (size_t)m * DM) + lane;
#pragma unroll
        for (int j = 0; j < 4; ++j) { const f32x4 h = v[j] * rstd * g4[j] + b4[j]; u32x2 w; w.x = pk2(h.x, h.y); w.y = pk2(h.z, h.w); o8[64 * j] = w; }
        if (lane == 0) { stats[2 * m] = mean; stats[2 * m + 1] = rstd; }
    }
    bf16_t* MB = (bf16_t*)(ws + WS_MEMB);
    for (int m = gw; m < MM; m += ngw) {
        const f32x4* xr = (const f32x4*)memrow(a, m) + lane; u32x2* o8 = (u32x2*)(MB + (size_t)m * DM) + lane;
#pragma unroll
        for (int j = 0; j < 4; ++j) { const f32x4 h = xr[64 * j]; u32x2 w; w.x = pk2(h.x, h.y); w.y = pk2(h.z, h.w); o8[64 * j] = w; }
    }
}

template <int MODE>
__device__ __forceinline__ void gemm_simple(const Args& a, const bf16_t* A, const bf16_t* Bt, int Mr, int N, int K, bf16_t* Cb, int ldc, int gw, int ngw, int lane) {
    const int nT = N / 32, tiles = (Mr / 32) * nT, r32 = lane & 31, hi = lane >> 5;
    const float* rope = (const float*)(a.ws + WS_ROPE); const float* stats = (const float*)(a.ws + WS_STATS);
    for (int t = gw; t < tiles; t += ngw) {
        const int tm = t / nT, tn = t % nT;
        const bf16_t* ap = A + (size_t)(tm * 32 + r32) * K + hi * 8; const bf16_t* bp = Bt + (size_t)(tn * 32 + r32) * K + hi * 8;
        f32x16 acc = {};
#pragma unroll 4
        for (int k = 0; k < K; k += 16) { const bf16x8 af = *(const bf16x8*)(ap + k), bfr = *(const bf16x8*)(bp + k); acc = __builtin_amdgcn_mfma_f32_32x32x16_bf16(af, bfr, acc, 0, 0, 0); }
        const int col = tn * 32 + r32;
#pragma unroll
        for (int r = 0; r < 16; ++r) {
            const int row = tm * 32 + (r & 3) + 8 * (r >> 2) + 4 * hi; float v = acc[r];
            if (MODE == 0) {
                const float vp = __shfl_xor(v, 8);
                if (col < 1024) { const int d = col & 63; if (d < 16) { const int tpos = row & (SEQ - 1), i = d & 7; const float c = rope[tpos * 16 + i], s = rope[tpos * 16 + 8 + i]; v = (d < 8) ? v * c - vp * s : v * c + vp * s; } }
                if (col < 512 || (col >= C_QMX && col < C_GMX)) v *= C2;
                Cb[(size_t)row * ldc + col] = (bf16_t)f2bf(v);
            } else if (MODE == 1) {
                Cb[(size_t)row * ldc + col] = (bf16_t)f2bf(v);
            } else {
                const float x = xrow(a, row)[col]; const float h = (x - stats[2 * row]) * stats[2 * row + 1] * a.in_g[col] + a.in_b[col];
                a.out[(size_t)row * DM + col] = ALPHA * h + v;
            }
        }
    }
}

__device__ __forceinline__ float lam_value(const Args& a, int lane) {
    const float p1 = wave_sum(a.lq1[lane] * a.lk1[lane]), p2 = wave_sum(a.lq2[lane] * a.lk2[lane]);
    return __expf(p1) - __expf(p2) + LAM_INIT;
}
__device__ __forceinline__ void mix_simple(const Args& a, char* lds, int gw, int ngw, int wave, int lane) {
    const bf16_t* P = (const bf16_t*)(a.ws + WS_PROJ); const bf16_t* KV = (const bf16_t*)(a.ws + WS_KV); bf16_t* MIX = (bf16_t*)(a.ws + WS_MIX);
    float* aw = (float*)(lds + wave * 8192);
    float* qs = (float*)(lds + 65536 + wave * 512);
    const float lam = lam_value(a, lane);
    for (int it = gw; it < M * 4; it += ngw) {
        const int m = it >> 2, h = it & 3, b = m / SEQ;
        const bf16_t* qp = P + (size_t)m * INW + C_QDA + h * 128;
        qs[lane] = bf2f(qp[lane]); qs[64 + lane] = bf2f(qp[64 + lane]);
        __builtin_amdgcn_s_waitcnt(0xC07F); asm volatile("" ::: "memory");
        const bf16_t* kb = P + (size_t)(b * SEQ + lane) * INW + C_KDA + h * 128;
#pragma unroll 1
        for (int c = 0; c < 2; ++c) {
            float sc[32];
#pragma unroll
            for (int i = 0; i < 32; ++i) {
                const bf16x8* kp = (const bf16x8*)(kb + (size_t)(64 * i) * INW + c * 64); float s0 = 0.f;
#pragma unroll
                for (int ch = 0; ch < 8; ++ch) { const bf16x8 k0 = kp[ch];
#pragma unroll
                    for (int e = 0; e < 8; ++e) s0 += bf2f((unsigned short)k0[e]) * qs[c * 64 + ch * 8 + e]; }
                sc[i] = s0;
            }
            float m0 = sc[0];
#pragma unroll
            for (int i = 1; i < 32; ++i) m0 = fmaxf(m0, sc[i]);
            m0 = wave_max(m0); float l0 = 0.f;
#pragma unroll
            for (int i = 0; i < 32; ++i) { sc[i] = exp2f(sc[i] - m0); l0 += sc[i]; }
            l0 = (c == 0 ? 1.f : -lam) / wave_sum(l0);
#pragma unroll
            for (int i = 0; i < 32; ++i) { if (c == 0) aw[lane + 64 * i] = sc[i] * l0; else aw[lane + 64 * i] += sc[i] * l0; }
        }
        __builtin_amdgcn_s_waitcnt(0xC07F); asm volatile("" ::: "memory");
        const unsigned* vp = (const unsigned*)(P + (size_t)(b * SEQ) * INW + C_VDA + h * 128) + lane;
        float o0 = 0.f, o1 = 0.f;
#pragma unroll 8
        for (int j = 0; j < SEQ; ++j) { const unsigned w = vp[(size_t)j * (INW / 2)]; const float p = aw[j]; o0 += p * bflo(w); o1 += p * bfhi(w); }
        const float ss = wave_sum(o0 * o0 + o1 * o1); const float rms = 1.f / sqrtf(ss * (1.f / 128.f) + LN_EPS);
        const unsigned gw2 = *((const unsigned*)(P + (size_t)m * INW + C_GDA + h * 128) + lane);
        const float r0 = o0 * rms * a.subln[2 * lane] * (1.f - LAM_INIT) * silu(bflo(gw2)), r1 = o1 * rms * a.subln[2 * lane + 1] * (1.f - LAM_INIT) * silu(bfhi(gw2));
        *((unsigned*)(MIX + (size_t)m * DM + h * 128) + lane) = pk2(r0, r1);
        __builtin_amdgcn_s_waitcnt(0xC07F); asm volatile("" ::: "memory");
    }
    for (int it = gw; it < M * 4; it += ngw) {
        const int m = it >> 2, h = it & 3, b = m / SEQ;
        qs[lane] = bf2f(P[(size_t)m * INW + C_QMX + h * 64 + lane]);
        __builtin_amdgcn_s_waitcnt(0xC07F); asm volatile("" ::: "memory");
        float sc[4]; const bf16_t* kb = KV + (size_t)(b * NMEM + lane) * KVW + h * 64;
#pragma unroll
        for (int i = 0; i < 4; ++i) { const bf16x8* kp = (const bf16x8*)(kb + (size_t)(64 * i) * KVW); float s0 = 0.f;
#pragma unroll
            for (int ch = 0; ch < 8; ++ch) { const bf16x8 k0 = kp[ch];
#pragma unroll
                for (int e = 0; e < 8; ++e) s0 += bf2f((unsigned short)k0[e]) * qs[ch * 8 + e]; }
            sc[i] = s0; }
        float mx = wave_max(fmaxf(fmaxf(sc[0], sc[1]), fmaxf(sc[2], sc[3]))); float l = 0.f;
#pragma unroll
        for (int i = 0; i < 4; ++i) { sc[i] = exp2f(sc[i] - mx); l += sc[i]; }
        l = 1.f / wave_sum(l);
#pragma unroll
        for (int i = 0; i < 4; ++i) aw[lane + 64 * i] = sc[i] * l;
        __builtin_amdgcn_s_waitcnt(0xC07F); asm volatile("" ::: "memory");
        const bf16_t* vp = KV + (size_t)(b * NMEM) * KVW + 256 + h * 64 + lane; float o = 0.f;
#pragma unroll 8
        for (int j = 0; j < NMEM; ++j) o += aw[j] * bf2f(vp[(size_t)j * KVW]);
        const float g = bf2f(P[(size_t)m * INW + C_GMX + h * 64 + lane]);
        MIX[(size_t)m * DM + 768 + h * 64 + lane] = (bf16_t)f2bf(o * silu(g));
        __builtin_amdgcn_s_waitcnt(0xC07F); asm volatile("" ::: "memory");
    }
    for (int m = gw; m < M; m += ngw) {
        const int t = m & (SEQ - 1);
        const bf16_t* pr = P + (size_t)m * INW;
#pragma unroll
        for (int e = 0; e < 4; ++e) { const int ch = 4 * lane + e;
            float u[3];
#pragma unroll
            for (int k = 0; k < 3; ++k) { const int tt = t + k - 1; u[k] = (tt >= 0 && tt < SEQ) ? bf2f(pr[(ptrdiff_t)(k - 1) * INW + C_CCV + ch]) * bf2f(pr[(ptrdiff_t)(k - 1) * INW + C_HCV + ch]) : 0.f; }
            const float y = a.conv_w[ch] * u[0] + a.conv_w[256 + ch] * u[1] + a.conv_w[512 + ch] * u[2];
            MIX[(size_t)m * DM + 512 + ch] = (bf16_t)f2bf(bf2f(pr[C_BCV + ch]) * y * silu(bf2f(pr[C_GCV + ch]))); }
    }
}

__device__ __forceinline__ void final_ln(const Args& a, int gw, int ngw, int lane) {
    f32x4 g4[4], b4[4];
#pragma unroll
    for (int j = 0; j < 4; ++j) { g4[j] = ((const f32x4*)a.ln_g)[64 * j + lane]; b4[j] = ((const f32x4*)a.ln_b)[64 * j + lane]; }
    for (int m = gw; m < M; m += ngw) {
        f32x4* xr = (f32x4*)(a.out + (size_t)m * DM) + lane;
        f32x4 v[4]; float s = 0.f;
#pragma unroll
        for (int j = 0; j < 4; ++j) { v[j] = xr[64 * j]; s += (v[j].x + v[j].y) + (v[j].z + v[j].w); }
        const float mean = wave_sum(s) * (1.f / DM); float s2 = 0.f;
#pragma unroll
        for (int j = 0; j < 4; ++j) { v[j] = v[j] - mean; s2 += (v[j].x * v[j].x + v[j].y * v[j].y) + (v[j].z * v[j].z + v[j].w * v[j].w); }
        const float rstd = 1.f / sqrtf(wave_sum(s2) * (1.f / DM) + LN_EPS);
#pragma unroll
        for (int j = 0; j < 4; ++j) xr[64 * j] = v[j] * rstd * g4[j] + b4[j];
    }
}

constexpr int NWAVES = 8, NTHREADS = NWAVES * 64;
constexpr int LDS_BYTES = 147456;

__global__ void __launch_bounds__(NTHREADS, 2) fwd_megakernel(Args a) {
    extern __shared__ __attribute__((aligned(16))) char lds[];
    cg::grid_group grid = cg::this_grid();
    const int tid = threadIdx.x, lane = tid & 63, wave = __builtin_amdgcn_readfirstlane(tid >> 6);
    const int gw = blockIdx.x * NWAVES + wave, ngw = gridDim.x * NWAVES;
    unsigned char* ws = a.ws;
    stage0(a, lds, gw, ngw, wave, lane);
    grid.sync();
    gemm_simple<0>(a, (const bf16_t*)(ws + WS_XN), (const bf16_t*)(ws + WS_WIN), M, INW, DM, (bf16_t*)(ws + WS_PROJ), INW, gw, ngw, lane);
    gemm_simple<1>(a, (const bf16_t*)(ws + WS_MEMB), (const bf16_t*)(ws + WS_WKV), MM, KVW, DM, (bf16_t*)(ws + WS_KV), KVW, gw, ngw, lane);
    grid.sync();
    mix_simple(a, lds, gw, ngw, wave, lane);
    grid.sync();
    gemm_simple<2>(a, (const bf16_t*)(ws + WS_MIX), (const bf16_t*)(ws + WS_WO), M, DM, DM, nullptr, DM, gw, ngw, lane);
    grid.sync();
    final_ln(a, gw, ngw, lane);
}

extern "C" void kernel_launch(void* const* d_in, const int* in_sizes, int n_in, void* d_out, int out_size, void* d_ws, size_t ws_size, hipStream_t stream) {
    static int grid_blocks = 0;
    if (grid_blocks == 0) {
        if (n_in != 17 || in_sizes[0] != M_P * DM || in_sizes[1] != (M - M_P) * DM || out_size != M * DM || ws_size < WS_END) {
            fprintf(stderr, "kernel_launch: shape mismatch n_in %d in0 %d in1 %d out %d ws %zu\n", n_in, n_in > 0 ? in_sizes[0] : -1, n_in > 1 ? in_sizes[1] : -1, out_size, ws_size); grid_blocks = -1; return; }
        int dev = 0, cus = 0, per_cu = 0;
        hipGetDevice(&dev);
        hipDeviceGetAttribute(&cus, hipDeviceAttributeMultiprocessorCount, dev);
        hipFuncSetAttribute((const void*)fwd_megakernel, hipFuncAttributeMaxDynamicSharedMemorySize, LDS_BYTES);
        hipOccupancyMaxActiveBlocksPerMultiprocessor(&per_cu, (const void*)fwd_megakernel, NTHREADS, LDS_BYTES);
        if (per_cu < 1) { fprintf(stderr, "kernel_launch: occupancy query says %d blocks per CU\n", per_cu); per_cu = 1; }
        grid_blocks = cus * 1;
        (void)hipGetLastError();
    }
    if (grid_blocks < 0) return;
    Args a{};
    a.x_p = (const float*)d_in[0]; a.x_s = (const float*)d_in[1]; a.mem_p = (const float*)d_in[2]; a.mem_s = (const float*)d_in[3];
    a.in_g = (const float*)d_in[4]; a.in_b = (const float*)d_in[5]; a.w_in = (const float*)d_in[6]; a.w_kv = (const float*)d_in[7];
    a.lq1 = (const float*)d_in[8]; a.lk1 = (const float*)d_in[9]; a.lq2 = (const float*)d_in[10]; a.lk2 = (const float*)d_in[11];
    a.subln = (const float*)d_in[12]; a.conv_w = (const float*)d_in[13]; a.w_o = (const float*)d_in[14]; a.ln_g = (const float*)d_in[15]; a.ln_b = (const float*)d_in[16];
    a.out = (float*)d_out; a.ws = (unsigned char*)d_ws;
    void* args[] = {&a};
    hipError_t e = hipLaunchCooperativeKernel((const void*)fwd_megakernel, dim3(grid_blocks), dim3(NTHREADS), args, LDS_BYTES, stream);
    if (e != hipSuccess) fprintf(stderr, "kernel_launch: cooperative launch failed: %s (grid %d)\n", hipGetErrorString(e), grid_blocks);
}
```

```cpp
#include <hip/hip_runtime.h>
#include <hip/hip_cooperative_groups.h>
#include <cstdio>
#include <cstdint>
namespace cg = cooperative_groups;

constexpr int DM = 1024, SEQ = 2048, NSEQ = 48, NSEQ_P = 32;
constexpr int M = NSEQ * SEQ;
constexpr int M_P = NSEQ_P * SEQ;
constexpr int NMEM = 256, MM = NSEQ * NMEM, MM_P = NSEQ_P * NMEM;
constexpr int INW = 3584, KVW = 512;
constexpr int C_QDA = 0, C_KDA = 512, C_VDA = 1024, C_GDA = 1536, C_BCV = 2048, C_CCV = 2304, C_HCV = 2560, C_GCV = 2816, C_QMX = 3072, C_GMX = 3328;
constexpr float LN_EPS = 1e-5f;
constexpr float ALPHA = 1.189207115002721f;
constexpr float LAM_INIT = 0.2f;
constexpr float C2 = 0.125f * 1.4426950408889634f;

constexpr size_t MiB = 1u << 20;
constexpr size_t WS_WIN = 1 * MiB;
constexpr size_t WS_WKV = 8 * MiB;
constexpr size_t WS_WO = 9 * MiB;
constexpr size_t WS_ROPE = 11 * MiB;
constexpr size_t WS_STATS = 12 * MiB;
constexpr size_t WS_KV = 13 * MiB;
constexpr size_t WS_MEMB = 25 * MiB;
constexpr size_t WS_XN = 49 * MiB;
constexpr size_t WS_MIX = WS_XN;
constexpr size_t WS_PROJ = 241 * MiB;
constexpr size_t WS_END = 913 * MiB;

typedef unsigned short bf16_t;
typedef short bf16x8 __attribute__((ext_vector_type(8)));
typedef float f32x4 __attribute__((ext_vector_type(4)));
typedef float f32x16 __attribute__((ext_vector_type(16)));
typedef unsigned u32x4 __attribute__((ext_vector_type(4)));
typedef unsigned u32x2 __attribute__((ext_vector_type(2)));

__device__ __forceinline__ unsigned f2bf(float f) { unsigned u = __builtin_bit_cast(unsigned, f); return (u + 0x7fffu + ((u >> 16) & 1u)) >> 16; }
__device__ __forceinline__ unsigned pk2(float lo, float hi) { return f2bf(lo) | (f2bf(hi) << 16); }
__device__ __forceinline__ float bf2f(unsigned short h) { return __builtin_bit_cast(float, (unsigned)h << 16); }
__device__ __forceinline__ float bflo(unsigned w) { return __builtin_bit_cast(float, w << 16); }
__device__ __forceinline__ float bfhi(unsigned w) { return __builtin_bit_cast(float, w & 0xffff0000u); }
__device__ __forceinline__ float wave_sum(float v) {
#pragma unroll
    for (int o = 1; o < 64; o <<= 1) v += __shfl_xor(v, o);
    return v;
}
__device__ __forceinline__ float wave_max(float v) {
#pragma unroll
    for (int o = 1; o < 64; o <<= 1) v = fmaxf(v, __shfl_xor(v, o));
    return v;
}
__device__ __forceinline__ float silu(float g) { return g / (1.f + __expf(-g)); }

struct Args {
    const float* x_p; const float* x_s; const float* mem_p; const float* mem_s; const float* in_g; const float* in_b;
    const float* w_in; const float* w_kv; const float* lq1; const float* lk1; const float* lq2; const float* lk2;
    const float* subln; const float* conv_w; const float* w_o; const float* ln_g; const float* ln_b;
    float* out; unsigned char* ws;
};

__device__ __forceinline__ const float* xrow(const Args& a, int m) { return m < M_P ? a.x_p + (size_t)m * DM : a.x_s + (size_t)(m - M_P) * DM; }
__device__ __forceinline__ const float* memrow(const Args& a, int m) { return m < MM_P ? a.mem_p + (size_t)m * DM : a.mem_s + (size_t)(m - MM_P) * DM; }

__device__ __forceinline__ void transpose_item(const float* W, int K, int N, bf16_t* WT, float* scr, int item, int lane) {
    const int nblk = N / 32, kb = item / nblk, nb = item % nblk, k0 = 64 * kb, n0 = 32 * nb;
#pragma unroll 8
    for (int i = 0; i < 32; ++i) { const int kk = 2 * i + (lane >> 5); scr[kk * 33 + (lane & 31)] = W[(size_t)(k0 + kk) * N + n0 + (lane & 31)]; }
    __builtin_amdgcn_s_waitcnt(0xC07F); asm volatile("" ::: "memory");
    const int c = lane & 7;
#pragma unroll
    for (int j = 0; j < 4; ++j) { const int n = (lane >> 3) + 8 * j; const float* s = scr + (8 * c) * 33 + n;
        u32x4 o; o.x = pk2(s[0 * 33], s[1 * 33]); o.y = pk2(s[2 * 33], s[3 * 33]); o.z = pk2(s[4 * 33], s[5 * 33]); o.w = pk2(s[6 * 33], s[7 * 33]);
        *(u32x4*)(WT + (size_t)(n0 + n) * K + k0 + 8 * c) = o; }
    __builtin_amdgcn_s_waitcnt(0xC07F); asm volatile("" ::: "memory");
}

__device__ __forceinline__ void stage0(const Args& a, char* lds, int gw, int ngw, int wave, int lane) {
    unsigned char* ws = a.ws;
    float* scr = (float*)(lds + wave * 16384);
    constexpr int I_IN = (DM / 64) * (INW / 32), I_KV = (DM / 64) * (KVW / 32), I_O = (DM / 64) * (DM / 32);
    for (int it = gw; it < I_IN + I_KV + I_O; it += ngw) {
        int r = it;
        if (r < I_IN) { transpose_item(a.w_in, DM, INW, (bf16_t*)(ws + WS_WIN), scr, r, lane); continue; } r -= I_IN;
        if (r < I_KV) { transpose_item(a.w_kv, DM, KVW, (bf16_t*)(ws + WS_WKV), scr, r, lane); continue; } r -= I_KV;
        transpose_item(a.w_o, DM, DM, (bf16_t*)(ws + WS_WO), scr, r, lane);
    }
    {
        const double cf[8] = {0.5403023058681398, 0.9812558362840286, 0.9992929765482185, 0.9999734086383661, 0.9999990000001666, 0.9999999623939693, 0.9999999985857865, 0.999999999946817};
        const double sf[8] = {0.8414709848078965, 0.19270958398204202, 0.0375971677311151, 0.007292600096474083, 0.0014142130909686214, 0.00027424817223841217, 5.31829589443792e-05, 1.0313385377029628e-05};
        float* rope = (float*)(ws + WS_ROPE);
        for (int idx = gw * 64 + lane; idx < SEQ * 8; idx += ngw * 64) {
            const int t = idx >> 3, i = idx & 7;
            double bc = 1.0, bs = 0.0;
#pragma unroll
            for (int k = 0; k < 8; ++k) if (k == i) { bc = cf[k]; bs = sf[k]; }
            double c = 1.0, s = 0.0;
            for (int bit = 0; bit < 11; ++bit) {
                if ((t >> bit) & 1) { const double nc = c * bc - s * bs, ns = s * bc + c * bs; c = nc; s = ns; }
                const double n2c = bc * bc - bs * bs, n2s = 2.0 * bs * bc; bc = n2c; bs = n2s;
            }
            rope[t * 16 + i] = (float)c; rope[t * 16 + 8 + i] = (float)s;
        }
    }
    bf16_t* XN = (bf16_t*)(ws + WS_XN); float* stats = (float*)(ws + WS_STATS);
    f32x4 g4[4], b4[4];
#pragma unroll
    for (int j = 0; j < 4; ++j) { g4[j] = ((const f32x4*)a.in_g)[64 * j + lane]; b4[j] = ((const f32x4*)a.in_b)[64 * j + lane]; }
    for (int m = gw; m < M; m += ngw) {
        const f32x4* xr = (const f32x4*)xrow(a, m) + lane;
        f32x4 v[4]; float s = 0.f;
#pragma unroll
        for (int j = 0; j < 4; ++j) { v[j] = xr[64 * j]; s += (v[j].x + v[j].y) + (v[j].z + v[j].w); }
        const float mean = wave_sum(s) * (1.f / DM); float s2 = 0.f;
#pragma unroll
        for (int j = 0; j < 4; ++j) { v[j] = v[j] - mean; s2 += (v[j].x * v[j].x + v[j].y * v[j].y) + (v[j].z * v[j].z + v[j].w * v[j].w); }
        const float rstd = 1.f / sqrtf(wave_sum(s2) * (1.f / DM) + LN_EPS);
        u32x2* o8 = (u32x2*)(XN + (size_t)m * DM) + lane;
#pragma unroll
        for (int j = 0; j < 4; ++j) { const f32x4 h = v[j] * rstd * g4[j] + b4[j]; u32x2 w; w.x = pk2(h.x, h.y); w.y = pk2(h.z, h.w); o8[64 * j] = w; }
        if (lane == 0) { stats[2 * m] = mean; stats[2 * m + 1] = rstd; }
    }
    bf16_t* MB = (bf16_t*)(ws + WS_MEMB);
    for (int m = gw; m < MM; m += ngw) {
        const f32x4* xr = (const f32x4*)memrow(a, m) + lane; u32x2* o8 = (u32x2*)(MB + (size_t)m * DM) + lane;
#pragma unroll
        for (int j = 0; j < 4; ++j) { const f32x4 h = xr[64 * j]; u32x2 w; w.x = pk2(h.x, h.y); w.y = pk2(h.z, h.w); o8[64 * j] = w; }
    }
}

namespace pg8 {
#define PG8_LAS __attribute__((address_space(3)))
typedef unsigned short bf16_t;
typedef short bf16x8 __attribute__((ext_vector_type(8)));
typedef float f32x4 __attribute__((ext_vector_type(4)));
typedef unsigned u32x4 __attribute__((ext_vector_type(4)));
constexpr int BM = 256, BK = 64, HALF = 128, HTB = HALF * BK * 2  , STAGE_BYTES = 8 * HTB, NXCD = 8, WGM = 8;

__host__ __device__ __forceinline__ int lds_byte(int r, int c) { const int st = (r >> 4) * 2 + (c >> 5), rr = r & 15, cc = c & 31, ob = rr * 64 + cc * 2; return st * 1024 + (ob ^ (((ob >> 9) & 1) << 5)); }
__host__ __device__ __forceinline__ void stage_rc(int b, int& R, int& C) { const int st = b / 1024, sb = b % 1024, swz = sb ^ (((sb >> 9) & 1) << 5); R = (st >> 1) * 16 + swz / 64; C = (st & 1) * 32 + (swz % 64) / 2; }
__host__ __device__ __forceinline__ int perm32(int rho) { const int n = rho >> 4, i = rho & 15; return 8 * (i >> 2) + 4 * n + (i & 3); }

struct Unit { int pm, pn; };
struct Gemm { const bf16_t* A; const bf16_t* Bt; int M, N, K; };

struct StaticOrder {
    int nM, nN, nwg, G, c;
    __host__ __device__ void init(int M, int N, int G_, int c_) { nM = M / BM; nN = N / BM; nwg = nM * nN; G = G_; c = c_; }
    __host__ __device__ bool next(int i, Unit& u) const {
        const long L = (long)i * G + c; if (L >= nwg) return false;
        int wgid = (int)L; { const int q = nwg / NXCD, r = nwg % NXCD, xcd = wgid % NXCD, off = wgid / NXCD; wgid = (xcd < r ? xcd * (q + 1) : r * (q + 1) + (xcd - r) * q) + off; }
        const int nig = WGM * nN, gid = wgid / nig, fm = gid * WGM, gsz = (nM - fm) < WGM ? (nM - fm) : WGM;
        u.pm = fm + ((wgid % nig) % gsz); u.pn = (wgid % nig) / gsz; return true;
    }
    __device__ __forceinline__ void a_ready(const Unit&) const {}
    __device__ __forceinline__ void done(const Unit&) const {}
};


__device__ __forceinline__ unsigned cvt_pk_bf16(float lo, float hi) { unsigned r; asm volatile("v_cvt_pk_bf16_f32 %0, %1, %2" : "=v"(r) : "v"(lo), "v"(hi)); return r; }

struct EpiProj {
    static constexpr bool PERM = true, AFTER_DRAIN = false;
    bf16_t* O; const float* rope;
    __device__ __forceinline__ void operator()(const f32x4 (&acc)[2][2][4][2], const Unit& u, int wr, int wc, int fr, int fq) const {
        const int row0 = u.pm * BM + wr * 64 + fr, col0 = u.pn * BM + wc * 32 + 8 * fq;
        const float sc = (u.pn < 2 || u.pn == 12) ? C2 : 1.f;
        const bool rot = (u.pn < 4) && ((wc & 1) == 0);
#pragma unroll
        for (int ai = 0; ai < 2; ++ai)
#pragma unroll
            for (int m = 0; m < 4; ++m) {
                const int row = row0 + ai * HALF + m * 16; bf16_t* rowp = O + (size_t)row * INW + col0;
                f32x4 c0 = {1.f, 1.f, 1.f, 1.f}, c1 = c0, s0 = {0.f, 0.f, 0.f, 0.f}, s1 = s0;
                if (rot) { const float* rp = rope + (row & (SEQ - 1)) * 16; c0 = *(const f32x4*)rp; c1 = *(const f32x4*)(rp + 4); s0 = *(const f32x4*)(rp + 8); s1 = *(const f32x4*)(rp + 12);
                    if (fq == 0) { s0 = -s0; s1 = -s1; } if (fq >= 2) { c0 = (f32x4){1.f, 1.f, 1.f, 1.f}; c1 = c0; s0 = (f32x4){0.f, 0.f, 0.f, 0.f}; s1 = s0; } }
#pragma unroll
                for (int bj = 0; bj < 2; ++bj) { f32x4 v0 = acc[ai][bj][m][0], v1 = acc[ai][bj][m][1];
                    if (rot) { f32x4 p0, p1;
#pragma unroll
                        for (int e = 0; e < 4; ++e) { p0[e] = __shfl_xor(v0[e], 16); p1[e] = __shfl_xor(v1[e], 16); }
                        v0 = v0 * c0 + p0 * s0; v1 = v1 * c1 + p1 * s1; }
                    v0 = v0 * sc; v1 = v1 * sc; u32x4 w; w.x = cvt_pk_bf16(v0[0], v0[1]); w.y = cvt_pk_bf16(v0[2], v0[3]); w.z = cvt_pk_bf16(v1[0], v1[1]); w.w = cvt_pk_bf16(v1[2], v1[3]);
                    *(u32x4*)(rowp + bj * HALF) = w; } }
    }
};
struct EpiPlain {
    static constexpr bool PERM = true, AFTER_DRAIN = false;
    bf16_t* O; int ldc;
    __device__ __forceinline__ void operator()(const f32x4 (&acc)[2][2][4][2], const Unit& u, int wr, int wc, int fr, int fq) const {
        const int row0 = u.pm * BM + wr * 64 + fr, col0 = u.pn * BM + wc * 32 + 8 * fq;
#pragma unroll
        for (int ai = 0; ai < 2; ++ai)
#pragma unroll
            for (int m = 0; m < 4; ++m) { bf16_t* rowp = O + (size_t)(row0 + ai * HALF + m * 16) * ldc + col0;
#pragma unroll
                for (int bj = 0; bj < 2; ++bj) { const f32x4 v0 = acc[ai][bj][m][0], v1 = acc[ai][bj][m][1];
                    u32x4 w; w.x = cvt_pk_bf16(v0[0], v0[1]); w.y = cvt_pk_bf16(v0[2], v0[3]); w.z = cvt_pk_bf16(v1[0], v1[1]); w.w = cvt_pk_bf16(v1[2], v1[3]);
                    *(u32x4*)(rowp + bj * HALF) = w; } }
    }
};
struct EpiOut {
    static constexpr bool PERM = false, AFTER_DRAIN = false;
    const float* xp; const float* xs; const float* stats; const float* g; const float* b; float* out;
    __device__ __forceinline__ void operator()(const f32x4 (&acc)[2][2][4][2], const Unit& u, int wr, int wc, int fr, int fq) const {
        const int row0 = u.pm * BM + wr * 64 + fr, col0 = u.pn * BM + wc * 32 + 4 * fq;
        f32x4 gv[2][2], bv[2][2];
#pragma unroll
        for (int bj = 0; bj < 2; ++bj)
#pragma unroll
            for (int n = 0; n < 2; ++n) { gv[bj][n] = *(const f32x4*)(g + col0 + bj * HALF + n * 16); bv[bj][n] = *(const f32x4*)(b + col0 + bj * HALF + n * 16); }
#pragma unroll
        for (int ai = 0; ai < 2; ++ai)
#pragma unroll
            for (int m = 0; m < 4; ++m) { const int row = row0 + ai * HALF + m * 16; const float mean = stats[2 * row], rstd = stats[2 * row + 1];
                const float* xr = (row < M_P ? xp + (size_t)row * DM : xs + (size_t)(row - M_P) * DM) + col0; float* orow = out + (size_t)row * DM + col0;
#pragma unroll
                for (int bj = 0; bj < 2; ++bj)
#pragma unroll
                    for (int n = 0; n < 2; ++n) { const f32x4 x4 = *(const f32x4*)(xr + bj * HALF + n * 16); const f32x4 h = (x4 - mean) * rstd * gv[bj][n] + bv[bj][n];
                        *(f32x4*)(orow + bj * HALF + n * 16) = h * ALPHA + acc[ai][bj][m][n]; }
                if (m & 1) asm volatile("" ::: "memory"); }
    }
};

template <class Epi, class Sched, bool ALIGN_EPI = false, bool SP2 = false>
__device__ __forceinline__ void gemm_phase(PG8_LAS unsigned char* lds, const Gemm g, const Sched& S, const Epi& E) {
    const int tid = threadIdx.x, wid = __builtin_amdgcn_readfirstlane(tid >> 6), lane = tid & 63, wr = wid >> 2, wc = wid & 3, fr = lane & 15, fq = lane >> 4;
    const int K = g.K, nt = K / BK;
    unsigned voffA[2], voffB[2];
#pragma unroll
    for (int i = 0; i < 2; ++i) { int R, C; stage_rc(tid * 16 + i * 8192, R, C); const int Rb = Epi::PERM ? ((R & ~31) + perm32(R & 31)) : R;
        voffA[i] = (unsigned)(R * K + C) * 2u; voffB[i] = (unsigned)(Rb * K + C) * 2u; }
    const size_t kstep = (size_t)(BK * 2);
    const size_t hstep = (size_t)HALF * K * 2;
    const size_t tstep = 2 * hstep;
    const unsigned ldsw = (unsigned)wid * 1024u;
    const int aoff = lds_byte(wr * 64 + fr, fq * 8), boff = lds_byte(wc * 32 + fr, fq * 8);
#define PG8_SA(b, h) (((b) * 2 + (h)) * HTB)
#define PG8_SB(b, h) ((4 + (b) * 2 + (h)) * HTB)
#define PG8_STAGE(bufoff, gbase, voff) do { _Pragma("unroll") for (int _i = 0; _i < 2; ++_i) \
        __builtin_amdgcn_global_load_lds((const unsigned*)((const char*)(gbase) + (voff)[_i]), (PG8_LAS unsigned*)(lds + (bufoff) + ldsw + _i * 8192), 16, 0, 0); } while (0)
#define PG8_LDA(dst, b, h) do { _Pragma("unroll") for (int m = 0; m < 4; ++m) _Pragma("unroll") for (int k = 0; k < 2; ++k) dst[m][k] = *(const PG8_LAS bf16x8*)(lds + PG8_SA(b, h) + aoff + m * 2048 + k * 1024); } while (0)
#define PG8_LDB(dst, b, h) do { _Pragma("unroll") for (int n = 0; n < 2; ++n) _Pragma("unroll") for (int k = 0; k < 2; ++k) dst[n][k] = *(const PG8_LAS bf16x8*)(lds + PG8_SB(b, h) + boff + n * 2048 + k * 1024); } while (0)
#define PG8_MMA(ai, bj, At, Bt) do { __builtin_amdgcn_s_setprio(1); _Pragma("unroll") for (int m = 0; m < 4; ++m) _Pragma("unroll") for (int n = 0; n < 2; ++n) _Pragma("unroll") for (int k = 0; k < 2; ++k) \
        acc[ai][bj][m][n] = __builtin_amdgcn_mfma_f32_16x16x32_bf16(Bt[n][k], At[m][k], acc[ai][bj][m][n], 0, 0, 0); __builtin_amdgcn_s_setprio(0); } while (0)
#define PG8_WAIT_V(n) asm volatile("s_waitcnt vmcnt(" #n ")" ::: "memory")
#define PG8_WAIT_L(n) asm volatile("s_waitcnt lgkmcnt(" #n ")" ::: "memory")
#define PG8_BAR __builtin_amdgcn_s_barrier()
#define PG8_SCHED __builtin_amdgcn_sched_barrier(0)
    Unit cur, nxt; int ui = 0;
    if (!S.next(0, cur)) return;
    f32x4 acc[2][2][4][2];
#pragma unroll
    for (int a = 0; a < 2; ++a)
#pragma unroll
        for (int b = 0; b < 2; ++b)
#pragma unroll
            for (int m = 0; m < 4; ++m)
#pragma unroll
                for (int n = 0; n < 2; ++n) acc[a][b][m][n] = (f32x4){0.f, 0.f, 0.f, 0.f};
    bf16x8 At[4][2], B0[2][2], B1[2][2];
    const char* cA = (const char*)g.A + (size_t)cur.pm * tstep; const char* cB = (const char*)g.Bt + (size_t)cur.pn * tstep;
    S.a_ready(cur);
    if constexpr (SP2) {
        PG8_STAGE(PG8_SB(0, 0), cB, voffB); PG8_STAGE(PG8_SB(0, 1), cB + hstep, voffB); PG8_STAGE(PG8_SA(0, 0), cA, voffA); PG8_STAGE(PG8_SA(0, 1), cA + hstep, voffA);
        if (wr == 1) PG8_BAR;
        PG8_WAIT_V(2); PG8_BAR;
        PG8_STAGE(PG8_SB(1, 0), cB + kstep, voffB); PG8_STAGE(PG8_SA(1, 0), cA + kstep, voffA); PG8_STAGE(PG8_SB(1, 1), cB + hstep + kstep, voffB);
        PG8_WAIT_V(6); PG8_BAR;
    } else {
        PG8_STAGE(PG8_SB(0, 0), cB, voffB); PG8_STAGE(PG8_SA(0, 0), cA, voffA); PG8_STAGE(PG8_SB(0, 1), cB + hstep, voffB); PG8_STAGE(PG8_SA(0, 1), cA + hstep, voffA);
        if (wr == 1) PG8_BAR;
        PG8_WAIT_V(4); PG8_BAR;
        PG8_STAGE(PG8_SB(1, 0), cB + kstep, voffB); PG8_STAGE(PG8_SA(1, 0), cA + kstep, voffA); PG8_STAGE(PG8_SB(1, 1), cB + hstep + kstep, voffB);
        PG8_WAIT_V(6); PG8_BAR;
    }
    for (;;) {
        const bool has_next = S.next(ui + 1, nxt);
        const char* nA = has_next ? (const char*)g.A + (size_t)nxt.pm * tstep : cA; const char* nB = has_next ? (const char*)g.Bt + (size_t)nxt.pn * tstep : cB;
        for (int t = 0; t < nt; t += 2) {
            const bool last = (t == nt - 2);
            const char* a1 = cA + (size_t)(t + 1) * kstep;
            const char* a2 = last ? nA : cA + (size_t)(t + 2) * kstep; const char* b2 = last ? nB : cB + (size_t)(t + 2) * kstep;
            const char* a3 = a2 + kstep; const char* b3 = b2 + kstep;
            if (last && has_next) S.a_ready(nxt);
            if constexpr (SP2) {
            PG8_LDB(B0, 0, 0); PG8_LDB(B1, 0, 1); PG8_SCHED; PG8_LDA(At, 0, 0); PG8_STAGE(PG8_SA(1, 1), a1 + hstep, voffA);
            PG8_WAIT_V(8); PG8_WAIT_L(0); PG8_BAR; PG8_MMA(0, 0, At, B0); PG8_MMA(0, 1, At, B1); PG8_BAR; PG8_SCHED;
            PG8_LDA(At, 0, 1); PG8_STAGE(PG8_SB(0, 0), b2, voffB); PG8_STAGE(PG8_SB(0, 1), b2 + hstep, voffB); PG8_STAGE(PG8_SA(0, 0), a2, voffA);
            PG8_WAIT_V(8); PG8_WAIT_L(0); PG8_BAR; PG8_MMA(1, 0, At, B0); PG8_MMA(1, 1, At, B1); PG8_BAR; PG8_SCHED;
            PG8_LDB(B0, 1, 0); PG8_LDB(B1, 1, 1); PG8_SCHED; PG8_LDA(At, 1, 0); PG8_STAGE(PG8_SA(0, 1), a2 + hstep, voffA);
            PG8_WAIT_V(8); PG8_WAIT_L(0); PG8_BAR; PG8_MMA(0, 0, At, B0); PG8_MMA(0, 1, At, B1); PG8_BAR; PG8_SCHED;
            PG8_LDA(At, 1, 1); PG8_STAGE(PG8_SB(1, 0), b3, voffB); PG8_STAGE(PG8_SB(1, 1), b3 + hstep, voffB); PG8_STAGE(PG8_SA(1, 0), a3, voffA);
            PG8_WAIT_V(8); PG8_WAIT_L(0); PG8_BAR; PG8_MMA(1, 0, At, B0); PG8_MMA(1, 1, At, B1); PG8_BAR; PG8_SCHED;
            } else {
            PG8_LDB(B0, 0, 0); PG8_SCHED; PG8_LDA(At, 0, 0); PG8_STAGE(PG8_SA(1, 1), a1 + hstep, voffA);
            PG8_WAIT_L(8); PG8_BAR; PG8_WAIT_L(0); PG8_MMA(0, 0, At, B0); PG8_BAR; PG8_SCHED;
            PG8_LDB(B1, 0, 1); PG8_STAGE(PG8_SB(0, 0), b2, voffB);
            PG8_BAR; PG8_WAIT_L(0); PG8_MMA(0, 1, At, B1); PG8_BAR;
            PG8_LDA(At, 0, 1); PG8_STAGE(PG8_SA(0, 0), a2, voffA);
            PG8_BAR; PG8_WAIT_L(0); PG8_MMA(1, 0, At, B0); PG8_BAR; PG8_SCHED;
            PG8_STAGE(PG8_SB(0, 1), b2 + hstep, voffB);
            PG8_WAIT_V(6); PG8_BAR; PG8_MMA(1, 1, At, B1); PG8_BAR;
            PG8_LDB(B0, 1, 0); PG8_SCHED; PG8_LDA(At, 1, 0); PG8_STAGE(PG8_SA(0, 1), a2 + hstep, voffA);
            PG8_WAIT_L(8); PG8_BAR; PG8_WAIT_L(0); PG8_MMA(0, 0, At, B0); PG8_BAR; PG8_SCHED;
            PG8_LDB(B1, 1, 1); PG8_STAGE(PG8_SB(1, 0), b3, voffB);
            PG8_BAR; PG8_WAIT_L(0); PG8_MMA(0, 1, At, B1); PG8_BAR;
            PG8_LDA(At, 1, 1); PG8_STAGE(PG8_SA(1, 0), a3, voffA);
            PG8_BAR; PG8_WAIT_L(0); PG8_MMA(1, 0, At, B0); PG8_BAR; PG8_SCHED;
            PG8_STAGE(PG8_SB(1, 1), b3 + hstep, voffB);
            PG8_WAIT_V(6); PG8_BAR; PG8_MMA(1, 1, At, B1); PG8_BAR;
            }
        }
        if constexpr (ALIGN_EPI) { if (wr == 0) PG8_BAR; }
        if constexpr (!Epi::AFTER_DRAIN) { E(acc, cur, wr, wc, fr, fq); S.done(cur); }
        if (!has_next) break;
#pragma unroll
        for (int a = 0; a < 2; ++a)
#pragma unroll
            for (int b = 0; b < 2; ++b)
#pragma unroll
                for (int m = 0; m < 4; ++m)
#pragma unroll
                    for (int n = 0; n < 2; ++n) acc[a][b][m][n] = (f32x4){0.f, 0.f, 0.f, 0.f};
        cur = nxt; cA = nA; cB = nB; ++ui;
        if constexpr (ALIGN_EPI) { if (wr == 1) PG8_BAR; }
    }
    PG8_WAIT_V(0);
    if constexpr (!ALIGN_EPI) { if (wr == 0) PG8_BAR; }
    PG8_BAR;
    if constexpr (Epi::AFTER_DRAIN) { E.fused(acc, cur, wr, wc, fr, fq, lds, wid, lane); S.done(cur); }
#undef PG8_SA
#undef PG8_SB
#undef PG8_STAGE
#undef PG8_LDA
#undef PG8_LDB
#undef PG8_MMA
#undef PG8_WAIT_V
#undef PG8_WAIT_L
#undef PG8_BAR
#undef PG8_SCHED
}
}

template <int MODE>
__device__ __forceinline__ void gemm_simple(const Args& a, const bf16_t* A, const bf16_t* Bt, int Mr, int N, int K, bf16_t* Cb, int ldc, int gw, int ngw, int lane) {
    const int nT = N / 32, tiles = (Mr / 32) * nT, r32 = lane & 31, hi = lane >> 5;
    const float* rope = (const float*)(a.ws + WS_ROPE); const float* stats = (const float*)(a.ws + WS_STATS);
    for (int t = gw; t < tiles; t += ngw) {
        const int tm = t / nT, tn = t % nT;
        const bf16_t* ap = A + (size_t)(tm * 32 + r32) * K + hi * 8; const bf16_t* bp = Bt + (size_t)(tn * 32 + r32) * K + hi * 8;
        f32x16 acc = {};
#pragma unroll 4
        for (int k = 0; k < K; k += 16) { const bf16x8 af = *(const bf16x8*)(ap + k), bfr = *(const bf16x8*)(bp + k); acc = __builtin_amdgcn_mfma_f32_32x32x16_bf16(af, bfr, acc, 0, 0, 0); }
        const int col = tn * 32 + r32;
#pragma unroll
        for (int r = 0; r < 16; ++r) {
            const int row = tm * 32 + (r & 3) + 8 * (r >> 2) + 4 * hi; float v = acc[r];
            if (MODE == 0) {
                const float vp = __shfl_xor(v, 8);
                if (col < 1024) { const int d = col & 63; if (d < 16) { const int tpos = row & (SEQ - 1), i = d & 7; const float c = rope[tpos * 16 + i], s = rope[tpos * 16 + 8 + i]; v = (d < 8) ? v * c - vp * s : v * c + vp * s; } }
                if (col < 512 || (col >= C_QMX && col < C_GMX)) v *= C2;
                Cb[(size_t)row * ldc + col] = (bf16_t)f2bf(v);
            } else if (MODE == 1) {
                Cb[(size_t)row * ldc + col] = (bf16_t)f2bf(v);
            } else {
                const float x = xrow(a, row)[col]; const float h = (x - stats[2 * row]) * stats[2 * row + 1] * a.in_g[col] + a.in_b[col];
                a.out[(size_t)row * DM + col] = ALPHA * h + v;
            }
        }
    }
}

__device__ __forceinline__ float lam_value(const Args& a, int lane) {
    const float p1 = wave_sum(a.lq1[lane] * a.lk1[lane]), p2 = wave_sum(a.lq2[lane] * a.lk2[lane]);
    return __expf(p1) - __expf(p2) + LAM_INIT;
}
__device__ __forceinline__ void mix_simple(const Args& a, char* lds, int gw, int ngw, int wave, int lane) {
    const bf16_t* P = (const bf16_t*)(a.ws + WS_PROJ); const bf16_t* KV = (const bf16_t*)(a.ws + WS_KV); bf16_t* MIX = (bf16_t*)(a.ws + WS_MIX);
    float* aw = (float*)(lds + wave * 8192);
    float* qs = (float*)(lds + 65536 + wave * 512);
    const float lam = lam_value(a, lane);
    for (int it = gw; it < M * 4; it += ngw) {
        const int m = it >> 2, h = it & 3, b = m / SEQ;
        const bf16_t* qp = P + (size_t)m * INW + C_QDA + h * 128;
        qs[lane] = bf2f(qp[lane]); qs[64 + lane] = bf2f(qp[64 + lane]);
        __builtin_amdgcn_s_waitcnt(0xC07F); asm volatile("" ::: "memory");
        const bf16_t* kb = P + (size_t)(b * SEQ + lane) * INW + C_KDA + h * 128;
#pragma unroll 1
        for (int c = 0; c < 2; ++c) {
            float sc[32];
#pragma unroll
            for (int i = 0; i < 32; ++i) {
                const bf16x8* kp = (const bf16x8*)(kb + (size_t)(64 * i) * INW + c * 64); float s0 = 0.f;
#pragma unroll
                for (int ch = 0; ch < 8; ++ch) { const bf16x8 k0 = kp[ch];
#pragma unroll
                    for (int e = 0; e < 8; ++e) s0 += bf2f((unsigned short)k0[e]) * qs[c * 64 + ch * 8 + e]; }
                sc[i] = s0;
            }
            float m0 = sc[0];
#pragma unroll
            for (int i = 1; i < 32; ++i) m0 = fmaxf(m0, sc[i]);
            m0 = wave_max(m0); float l0 = 0.f;
#pragma unroll
            for (int i = 0; i < 32; ++i) { sc[i] = exp2f(sc[i] - m0); l0 += sc[i]; }
            l0 = (c == 0 ? 1.f : -lam) / wave_sum(l0);
#pragma unroll
            for (int i = 0; i < 32; ++i) { if (c == 0) aw[lane + 64 * i] = sc[i] * l0; else aw[lane + 64 * i] += sc[i] * l0; }
        }
        __builtin_amdgcn_s_waitcnt(0xC07F); asm volatile("" ::: "memory");
        const unsigned* vp = (const unsigned*)(P + (size_t)(b * SEQ) * INW + C_VDA + h * 128) + lane;
        float o0 = 0.f, o1 = 0.f;
#pragma unroll 8
        for (int j = 0; j < SEQ; ++j) { const unsigned w = vp[(size_t)j * (INW / 2)]; const float p = aw[j]; o0 += p * bflo(w); o1 += p * bfhi(w); }
        const float ss = wave_sum(o0 * o0 + o1 * o1); const float rms = 1.f / sqrtf(ss * (1.f / 128.f) + LN_EPS);
        const unsigned gw2 = *((const unsigned*)(P + (size_t)m * INW + C_GDA + h * 128) + lane);
        const float r0 = o0 * rms * a.subln[2 * lane] * (1.f - LAM_INIT) * silu(bflo(gw2)), r1 = o1 * rms * a.subln[2 * lane + 1] * (1.f - LAM_INIT) * silu(bfhi(gw2));
        *((unsigned*)(MIX + (size_t)m * DM + h * 128) + lane) = pk2(r0, r1);
        __builtin_amdgcn_s_waitcnt(0xC07F); asm volatile("" ::: "memory");
    }
    for (int it = gw; it < M * 4; it += ngw) {
        const int m = it >> 2, h = it & 3, b = m / SEQ;
        qs[lane] = bf2f(P[(size_t)m * INW + C_QMX + h * 64 + lane]);
        __builtin_amdgcn_s_waitcnt(0xC07F); asm volatile("" ::: "memory");
        float sc[4]; const bf16_t* kb = KV + (size_t)(b * NMEM + lane) * KVW + h * 64;
#pragma unroll
        for (int i = 0; i < 4; ++i) { const bf16x8* kp = (const bf16x8*)(kb + (size_t)(64 * i) * KVW); float s0 = 0.f;
#pragma unroll
            for (int ch = 0; ch < 8; ++ch) { const bf16x8 k0 = kp[ch];
#pragma unroll
                for (int e = 0; e < 8; ++e) s0 += bf2f((unsigned short)k0[e]) * qs[ch * 8 + e]; }
            sc[i] = s0; }
        float mx = wave_max(fmaxf(fmaxf(sc[0], sc[1]), fmaxf(sc[2], sc[3]))); float l = 0.f;
#pragma unroll
        for (int i = 0; i < 4; ++i) { sc[i] = exp2f(sc[i] - mx); l += sc[i]; }
        l = 1.f / wave_sum(l);
#pragma unroll
        for (int i = 0; i < 4; ++i) aw[lane + 64 * i] = sc[i] * l;
        __builtin_amdgcn_s_waitcnt(0xC07F); asm volatile("" ::: "memory");
        const bf16_t* vp = KV + (size_t)(b * NMEM) * KVW + 256 + h * 64 + lane; float o = 0.f;
#pragma unroll 8
        for (int j = 0; j < NMEM; ++j) o += aw[j] * bf2f(vp[(size_t)j * KVW]);
        const float g = bf2f(P[(size_t)m * INW + C_GMX + h * 64 + lane]);
        MIX[(size_t)m * DM + 768 + h * 64 + lane] = (bf16_t)f2bf(o * silu(g));
        __builtin_amdgcn_s_waitcnt(0xC07F); asm volatile("" ::: "memory");
    }
    for (int m = gw; m < M; m += ngw) {
        const int t = m & (SEQ - 1);
        const bf16_t* pr = P + (size_t)m * INW;
#pragma unroll
        for (int e = 0; e < 4; ++e) { const int ch = 4 * lane + e;
            float u[3];
#pragma unroll
            for (int k = 0; k < 3; ++k) { const int tt = t + k - 1; u[k] = (tt >= 0 && tt < SEQ) ? bf2f(pr[(ptrdiff_t)(k - 1) * INW + C_CCV + ch]) * bf2f(pr[(ptrdiff_t)(k - 1) * INW + C_HCV + ch]) : 0.f; }
            const float y = a.conv_w[ch] * u[0] + a.conv_w[256 + ch] * u[1] + a.conv_w[512 + ch] * u[2];
            MIX[(size_t)m * DM + 512 + ch] = (bf16_t)f2bf(bf2f(pr[C_BCV + ch]) * y * silu(bf2f(pr[C_GCV + ch]))); }
    }
}

__device__ __forceinline__ void final_ln(const Args& a, int gw, int ngw, int lane) {
    f32x4 g4[4], b4[4];
#pragma unroll
    for (int j = 0; j < 4; ++j) { g4[j] = ((const f32x4*)a.ln_g)[64 * j + lane]; b4[j] = ((const f32x4*)a.ln_b)[64 * j + lane]; }
    for (int m = gw; m < M; m += ngw) {
        f32x4* xr = (f32x4*)(a.out + (size_t)m * DM) + lane;
        f32x4 v[4]; float s = 0.f;
#pragma unroll
        for (int j = 0; j < 4; ++j) { v[j] = xr[64 * j]; s += (v[j].x + v[j].y) + (v[j].z + v[j].w); }
        const float mean = wave_sum(s) * (1.f / DM); float s2 = 0.f;
#pragma unroll
        for (int j = 0; j < 4; ++j) { v[j] = v[j] - mean; s2 += (v[j].x * v[j].x + v[j].y * v[j].y) + (v[j].z * v[j].z + v[j].w * v[j].w); }
        const float rstd = 1.f / sqrtf(wave_sum(s2) * (1.f / DM) + LN_EPS);
#pragma unroll
        for (int j = 0; j < 4; ++j) xr[64 * j] = v[j] * rstd * g4[j] + b4[j];
    }
}

constexpr int NWAVES = 8, NTHREADS = NWAVES * 64;
constexpr int LDS_BYTES = 147456;

__global__ void __launch_bounds__(NTHREADS, 2) fwd_megakernel(Args a) {
    extern __shared__ __attribute__((aligned(16))) char lds[];
    cg::grid_group grid = cg::this_grid();
    const int tid = threadIdx.x, lane = tid & 63, wave = __builtin_amdgcn_readfirstlane(tid >> 6);
    const int gw = blockIdx.x * NWAVES + wave, ngw = gridDim.x * NWAVES;
    unsigned char* ws = a.ws;
    stage0(a, lds, gw, ngw, wave, lane);
    grid.sync();
    {
        pg8::Gemm g{(const bf16_t*)(ws + WS_XN), (const bf16_t*)(ws + WS_WIN), M, INW, DM}; pg8::StaticOrder S; S.init(M, INW, (int)gridDim.x, (int)blockIdx.x);
        pg8::EpiProj E{(bf16_t*)(ws + WS_PROJ), (const float*)(ws + WS_ROPE)};
        pg8::gemm_phase<pg8::EpiProj, pg8::StaticOrder, true, true>((PG8_LAS unsigned char*)lds, g, S, E);
    }
    {
        pg8::Gemm g{(const bf16_t*)(ws + WS_MEMB), (const bf16_t*)(ws + WS_WKV), MM, KVW, DM}; pg8::StaticOrder S; S.init(MM, KVW, (int)gridDim.x, (int)blockIdx.x);
        pg8::EpiPlain E{(bf16_t*)(ws + WS_KV), KVW};
        pg8::gemm_phase<pg8::EpiPlain, pg8::StaticOrder, true, true>((PG8_LAS unsigned char*)lds, g, S, E);
    }
    grid.sync();
    mix_simple(a, lds, gw, ngw, wave, lane);
    grid.sync();
    {
        pg8::Gemm g{(const bf16_t*)(ws + WS_MIX), (const bf16_t*)(ws + WS_WO), M, DM, DM}; pg8::StaticOrder S; S.init(M, DM, (int)gridDim.x, (int)blockIdx.x);
        pg8::EpiOut E{a.x_p, a.x_s, (const float*)(ws + WS_STATS), a.in_g, a.in_b, a.out};
        pg8::gemm_phase<pg8::EpiOut, pg8::StaticOrder, true, true>((PG8_LAS unsigned char*)lds, g, S, E);
    }
    grid.sync();
    final_ln(a, gw, ngw, lane);
}

extern "C" void kernel_launch(void* const* d_in, const int* in_sizes, int n_in, void* d_out, int out_size, void* d_ws, size_t ws_size, hipStream_t stream) {
    static int grid_blocks = 0;
    if (grid_blocks == 0) {
        if (n_in != 17 || in_sizes[0] != M_P * DM || in_sizes[1] != (M - M_P) * DM || out_size != M * DM || ws_size < WS_END) {
            fprintf(stderr, "kernel_launch: shape mismatch n_in %d in0 %d in1 %d out %d ws %zu\n", n_in, n_in > 0 ? in_sizes[0] : -1, n_in > 1 ? in_sizes[1] : -1, out_size, ws_size); grid_blocks = -1; return; }
        int dev = 0, cus = 0, per_cu = 0;
        hipGetDevice(&dev);
        hipDeviceGetAttribute(&cus, hipDeviceAttributeMultiprocessorCount, dev);
        hipFuncSetAttribute((const void*)fwd_megakernel, hipFuncAttributeMaxDynamicSharedMemorySize, LDS_BYTES);
        hipOccupancyMaxActiveBlocksPerMultiprocessor(&per_cu, (const void*)fwd_megakernel, NTHREADS, LDS_BYTES);
        if (per_cu < 1) { fprintf(stderr, "kernel_launch: occupancy query says %d blocks per CU\n", per_cu); per_cu = 1; }
        grid_blocks = cus * 1;
        (void)hipGetLastError();
    }
    if (grid_blocks < 0) return;
    Args a{};
    a.x_p = (const float*)d_in[0]; a.x_s = (const float*)d_in[1]; a.mem_p = (const float*)d_in[2]; a.mem_s = (const float*)d_in[3];
    a.in_g = (const float*)d_in[4]; a.in_b = (const float*)d_in[5]; a.w_in = (const float*)d_in[6]; a.w_kv = (const float*)d_in[7];
    a.lq1 = (const float*)d_in[8]; a.lk1 = (const float*)d_in[9]; a.lq2 = (const float*)d_in[10]; a.lk2 = (const float*)d_in[11];
    a.subln = (const float*)d_in[12]; a.conv_w = (const float*)d_in[13]; a.w_o = (const float*)d_in[14]; a.ln_g = (const float*)d_in[15]; a.ln_b = (const float*)d_in[16];
    a.out = (float*)d_out; a.ws = (unsigned char*)d_ws;
    void* args[] = {&a};
    hipError_t e = hipLaunchCooperativeKernel((const void*)fwd_megakernel, dim3(grid_blocks), dim3(NTHREADS), args, LDS_BYTES, stream);
    if (e != hipSuccess) fprintf(stderr, "kernel_launch: cooperative launch failed: %s (grid %d)\n", hipGetErrorString(e), grid_blocks);
}
```

```cpp
#include <hip/hip_runtime.h>
#include <hip/hip_cooperative_groups.h>
#include <cstdio>
#include <cstdint>
namespace cg = cooperative_groups;

constexpr int DM = 1024, SEQ = 2048, NSEQ = 48, NSEQ_P = 32;
constexpr int M = NSEQ * SEQ;
constexpr int M_P = NSEQ_P * SEQ;
constexpr int NMEM = 256, MM = NSEQ * NMEM, MM_P = NSEQ_P * NMEM;
constexpr int INW = 3584, KVW = 512;
constexpr int C_QDA = 0, C_KDA = 512, C_VDA = 1024, C_GDA = 1536, C_BCV = 2048, C_CCV = 2304, C_HCV = 2560, C_GCV = 2816, C_QMX = 3072, C_GMX = 3328;
constexpr float LN_EPS = 1e-5f;
constexpr float ALPHA = 1.189207115002721f;
constexpr float LAM_INIT = 0.2f;
constexpr float C2 = 0.125f * 1.4426950408889634f;

constexpr size_t MiB = 1u << 20;
constexpr size_t WS_WIN = 1 * MiB;
constexpr size_t WS_WKV = 8 * MiB;
constexpr size_t WS_WO = 9 * MiB;
constexpr size_t WS_ROPE = 11 * MiB;
constexpr size_t WS_STATS = 12 * MiB;
constexpr size_t WS_KV = 13 * MiB;
constexpr size_t WS_MEMB = 25 * MiB;
constexpr size_t WS_XN = 49 * MiB;
constexpr size_t WS_MIX = WS_XN;
constexpr size_t WS_PROJ = 241 * MiB;
constexpr size_t WS_END = 913 * MiB;

typedef unsigned short bf16_t;
typedef short bf16x8 __attribute__((ext_vector_type(8)));
typedef float f32x4 __attribute__((ext_vector_type(4)));
typedef float f32x16 __attribute__((ext_vector_type(16)));
typedef unsigned u32x4 __attribute__((ext_vector_type(4)));
typedef unsigned u32x2 __attribute__((ext_vector_type(2)));

__device__ __forceinline__ unsigned f2bf(float f) { unsigned u = __builtin_bit_cast(unsigned, f); return (u + 0x7fffu + ((u >> 16) & 1u)) >> 16; }
__device__ __forceinline__ unsigned pk2(float lo, float hi) { return f2bf(lo) | (f2bf(hi) << 16); }
__device__ __forceinline__ float bf2f(unsigned short h) { return __builtin_bit_cast(float, (unsigned)h << 16); }
__device__ __forceinline__ float bflo(unsigned w) { return __builtin_bit_cast(float, w << 16); }
__device__ __forceinline__ float bfhi(unsigned w) { return __builtin_bit_cast(float, w & 0xffff0000u); }
__device__ __forceinline__ float wave_sum(float v) {
#pragma unroll
    for (int o = 1; o < 64; o <<= 1) v += __shfl_xor(v, o);
    return v;
}
__device__ __forceinline__ float wave_max(float v) {
#pragma unroll
    for (int o = 1; o < 64; o <<= 1) v = fmaxf(v, __shfl_xor(v, o));
    return v;
}
__device__ __forceinline__ float silu(float g) { return g / (1.f + __expf(-g)); }

struct Args {
    const float* x_p; const float* x_s; const float* mem_p; const float* mem_s; const float* in_g; const float* in_b;
    const float* w_in; const float* w_kv; const float* lq1; const float* lk1; const float* lq2; const float* lk2;
    const float* subln; const float* conv_w; const float* w_o; const float* ln_g; const float* ln_b;
    float* out; unsigned char* ws;
};

__device__ __forceinline__ const float* xrow(const Args& a, int m) { return m < M_P ? a.x_p + (size_t)m * DM : a.x_s + (size_t)(m - M_P) * DM; }
__device__ __forceinline__ const float* memrow(const Args& a, int m) { return m < MM_P ? a.mem_p + (size_t)m * DM : a.mem_s + (size_t)(m - MM_P) * DM; }

__device__ __forceinline__ void transpose_item(const float* W, int K, int N, bf16_t* WT, float* scr, int item, int lane) {
    const int nblk = N / 32, kb = item / nblk, nb = item % nblk, k0 = 64 * kb, n0 = 32 * nb;
#pragma unroll 8
    for (int i = 0; i < 32; ++i) { const int kk = 2 * i + (lane >> 5); scr[kk * 33 + (lane & 31)] = W[(size_t)(k0 + kk) * N + n0 + (lane & 31)]; }
    __builtin_amdgcn_s_waitcnt(0xC07F); asm volatile("" ::: "memory");
    const int c = lane & 7;
#pragma unroll
    for (int j = 0; j < 4; ++j) { const int n = (lane >> 3) + 8 * j; const float* s = scr + (8 * c) * 33 + n;
        u32x4 o; o.x = pk2(s[0 * 33], s[1 * 33]); o.y = pk2(s[2 * 33], s[3 * 33]); o.z = pk2(s[4 * 33], s[5 * 33]); o.w = pk2(s[6 * 33], s[7 * 33]);
        *(u32x4*)(WT + (size_t)(n0 + n) * K + k0 + 8 * c) = o; }
    __builtin_amdgcn_s_waitcnt(0xC07F); asm volatile("" ::: "memory");
}

__device__ __forceinline__ void stage0(const Args& a, char* lds, int gw, int ngw, int wave, int lane) {
    unsigned char* ws = a.ws;
    float* scr = (float*)(lds + wave * 16384);
    constexpr int I_IN = (DM / 64) * (INW / 32), I_KV = (DM / 64) * (KVW / 32), I_O = (DM / 64) * (DM / 32);
    for (int it = gw; it < I_IN + I_KV + I_O; it += ngw) {
        int r = it;
        if (r < I_IN) { transpose_item(a.w_in, DM, INW, (bf16_t*)(ws + WS_WIN), scr, r, lane); continue; } r -= I_IN;
        if (r < I_KV) { transpose_item(a.w_kv, DM, KVW, (bf16_t*)(ws + WS_WKV), scr, r, lane); continue; } r -= I_KV;
        transpose_item(a.w_o, DM, DM, (bf16_t*)(ws + WS_WO), scr, r, lane);
    }
    {
        const double cf[8] = {0.5403023058681398, 0.9812558362840286, 0.9992929765482185, 0.9999734086383661, 0.9999990000001666, 0.9999999623939693, 0.9999999985857865, 0.999999999946817};
        const double sf[8] = {0.8414709848078965, 0.19270958398204202, 0.0375971677311151, 0.007292600096474083, 0.0014142130909686214, 0.00027424817223841217, 5.31829589443792e-05, 1.0313385377029628e-05};
        float* rope = (float*)(ws + WS_ROPE);
        for (int idx = gw * 64 + lane; idx < SEQ * 8; idx += ngw * 64) {
            const int t = idx >> 3, i = idx & 7;
            double bc = 1.0, bs = 0.0;
#pragma unroll
            for (int k = 0; k < 8; ++k) if (k == i) { bc = cf[k]; bs = sf[k]; }
            double c = 1.0, s = 0.0;
            for (int bit = 0; bit < 11; ++bit) {
                if ((t >> bit) & 1) { const double nc = c * bc - s * bs, ns = s * bc + c * bs; c = nc; s = ns; }
                const double n2c = bc * bc - bs * bs, n2s = 2.0 * bs * bc; bc = n2c; bs = n2s;
            }
            rope[t * 16 + i] = (float)c; rope[t * 16 + 8 + i] = (float)s;
        }
    }
    bf16_t* XN = (bf16_t*)(ws + WS_XN); float* stats = (float*)(ws + WS_STATS);
    f32x4 g4[4], b4[4];
#pragma unroll
    for (int j = 0; j < 4; ++j) { g4[j] = ((const f32x4*)a.in_g)[64 * j + lane]; b4[j] = ((const f32x4*)a.in_b)[64 * j + lane]; }
    for (int m = gw; m < M; m += ngw) {
        const f32x4* xr = (const f32x4*)xrow(a, m) + lane;
        f32x4 v[4]; float s = 0.f;
#pragma unroll
        for (int j = 0; j < 4; ++j) { v[j] = xr[64 * j]; s += (v[j].x + v[j].y) + (v[j].z + v[j].w); }
        const float mean = wave_sum(s) * (1.f / DM); float s2 = 0.f;
#pragma unroll
        for (int j = 0; j < 4; ++j) { v[j] = v[j] - mean; s2 += (v[j].x * v[j].x + v[j].y * v[j].y) + (v[j].z * v[j].z + v[j].w * v[j].w); }
        const float rstd = 1.f / sqrtf(wave_sum(s2) * (1.f / DM) + LN_EPS);
        u32x2* o8 = (u32x2*)(XN + (size_t)m * DM) + lane;
#pragma unroll
        for (int j = 0; j < 4; ++j) { const f32x4 h = v[j] * rstd * g4[j] + b4[j]; u32x2 w; w.x = pk2(h.x, h.y); w.y = pk2(h.z, h.w); o8[64 * j] = w; }
        if (lane == 0) { stats[2 * m] = mean; stats[2 * m + 1] = rstd; }
    }
    bf16_t* MB = (bf16_t*)(ws + WS_MEMB);
    for (int m = gw; m < MM; m += ngw) {
        const f32x4* xr = (const f32x4*)memrow(a, m) + lane; u32x2* o8 = (u32x2*)(MB + (size_t)m * DM) + lane;
#pragma unroll
        for (int j = 0; j < 4; ++j) { const f32x4 h = xr[64 * j]; u32x2 w; w.x = pk2(h.x, h.y); w.y = pk2(h.z, h.w); o8[64 * j] = w; }
    }
}

namespace pg8 {
#define PG8_LAS __attribute__((address_space(3)))
typedef unsigned short bf16_t;
typedef short bf16x8 __attribute__((ext_vector_type(8)));
typedef float f32x4 __attribute__((ext_vector_type(4)));
typedef unsigned u32x4 __attribute__((ext_vector_type(4)));
constexpr int BM = 256, BK = 64, HALF = 128, HTB = HALF * BK * 2  , STAGE_BYTES = 8 * HTB, NXCD = 8, WGM = 8;

__host__ __device__ __forceinline__ int lds_byte(int r, int c) { const int st = (r >> 4) * 2 + (c >> 5), rr = r & 15, cc = c & 31, ob = rr * 64 + cc * 2; return st * 1024 + (ob ^ (((ob >> 9) & 1) << 5)); }
__host__ __device__ __forceinline__ void stage_rc(int b, int& R, int& C) { const int st = b / 1024, sb = b % 1024, swz = sb ^ (((sb >> 9) & 1) << 5); R = (st >> 1) * 16 + swz / 64; C = (st & 1) * 32 + (swz % 64) / 2; }
__host__ __device__ __forceinline__ int perm32(int rho) { const int n = rho >> 4, i = rho & 15; return 8 * (i >> 2) + 4 * n + (i & 3); }

struct Unit { int pm, pn; };
struct Gemm { const bf16_t* A; const bf16_t* Bt; int M, N, K; };

struct StaticOrder {
    int nM, nN, nwg, G, c;
    __host__ __device__ void init(int M, int N, int G_, int c_) { nM = M / BM; nN = N / BM; nwg = nM * nN; G = G_; c = c_; }
    __host__ __device__ bool next(int i, Unit& u) const {
        const long L = (long)i * G + c; if (L >= nwg) return false;
        int wgid = (int)L; { const int q = nwg / NXCD, r = nwg % NXCD, xcd = wgid % NXCD, off = wgid / NXCD; wgid = (xcd < r ? xcd * (q + 1) : r * (q + 1) + (xcd - r) * q) + off; }
        const int nig = WGM * nN, gid = wgid / nig, fm = gid * WGM, gsz = (nM - fm) < WGM ? (nM - fm) : WGM;
        u.pm = fm + ((wgid % nig) % gsz); u.pn = (wgid % nig) / gsz; return true;
    }
    __device__ __forceinline__ void a_ready(const Unit&) const {}
    __device__ __forceinline__ void done(const Unit&) const {}
};


__device__ __forceinline__ unsigned cvt_pk_bf16(float lo, float hi) { unsigned r; asm volatile("v_cvt_pk_bf16_f32 %0, %1, %2" : "=v"(r) : "v"(lo), "v"(hi)); return r; }

struct EpiProj {
    static constexpr bool PERM = true, AFTER_DRAIN = false;
    bf16_t* O; const float* rope;
    __device__ __forceinline__ void operator()(const f32x4 (&acc)[2][2][4][2], const Unit& u, int wr, int wc, int fr, int fq) const {
        const int row0 = u.pm * BM + wr * 64 + fr, col0 = u.pn * BM + wc * 32 + 8 * fq;
        const float sc = (u.pn < 2 || u.pn == 12) ? C2 : 1.f;
        const bool rot = (u.pn < 4) && ((wc & 1) == 0);
#pragma unroll
        for (int ai = 0; ai < 2; ++ai)
#pragma unroll
            for (int m = 0; m < 4; ++m) {
                const int row = row0 + ai * HALF + m * 16; bf16_t* rowp = O + (size_t)row * INW + col0;
                f32x4 c0 = {1.f, 1.f, 1.f, 1.f}, c1 = c0, s0 = {0.f, 0.f, 0.f, 0.f}, s1 = s0;
                if (rot) { const float* rp = rope + (row & (SEQ - 1)) * 16; c0 = *(const f32x4*)rp; c1 = *(const f32x4*)(rp + 4); s0 = *(const f32x4*)(rp + 8); s1 = *(const f32x4*)(rp + 12);
                    if (fq == 0) { s0 = -s0; s1 = -s1; } if (fq >= 2) { c0 = (f32x4){1.f, 1.f, 1.f, 1.f}; c1 = c0; s0 = (f32x4){0.f, 0.f, 0.f, 0.f}; s1 = s0; } }
#pragma unroll
                for (int bj = 0; bj < 2; ++bj) { f32x4 v0 = acc[ai][bj][m][0], v1 = acc[ai][bj][m][1];
                    if (rot) { f32x4 p0, p1;
#pragma unroll
                        for (int e = 0; e < 4; ++e) { p0[e] = __shfl_xor(v0[e], 16); p1[e] = __shfl_xor(v1[e], 16); }
                        v0 = v0 * c0 + p0 * s0; v1 = v1 * c1 + p1 * s1; }
                    v0 = v0 * sc; v1 = v1 * sc; u32x4 w; w.x = cvt_pk_bf16(v0[0], v0[1]); w.y = cvt_pk_bf16(v0[2], v0[3]); w.z = cvt_pk_bf16(v1[0], v1[1]); w.w = cvt_pk_bf16(v1[2], v1[3]);
                    *(u32x4*)(rowp + bj * HALF) = w; } }
    }
};
struct EpiPlain {
    static constexpr bool PERM = true, AFTER_DRAIN = false;
    bf16_t* O; int ldc;
    __device__ __forceinline__ void operator()(const f32x4 (&acc)[2][2][4][2], const Unit& u, int wr, int wc, int fr, int fq) const {
        const int row0 = u.pm * BM + wr * 64 + fr, col0 = u.pn * BM + wc * 32 + 8 * fq;
#pragma unroll
        for (int ai = 0; ai < 2; ++ai)
#pragma unroll
            for (int m = 0; m < 4; ++m) { bf16_t* rowp = O + (size_t)(row0 + ai * HALF + m * 16) * ldc + col0;
#pragma unroll
                for (int bj = 0; bj < 2; ++bj) { const f32x4 v0 = acc[ai][bj][m][0], v1 = acc[ai][bj][m][1];
                    u32x4 w; w.x = cvt_pk_bf16(v0[0], v0[1]); w.y = cvt_pk_bf16(v0[2], v0[3]); w.z = cvt_pk_bf16(v1[0], v1[1]); w.w = cvt_pk_bf16(v1[2], v1[3]);
                    *(u32x4*)(rowp + bj * HALF) = w; } }
    }
};
struct EpiOut {
    static constexpr bool PERM = false, AFTER_DRAIN = false;
    const float* xp; const float* xs; const float* stats; const float* g; const float* b; float* out;
    __device__ __forceinline__ void operator()(const f32x4 (&acc)[2][2][4][2], const Unit& u, int wr, int wc, int fr, int fq) const {
        const int row0 = u.pm * BM + wr * 64 + fr, col0 = u.pn * BM + wc * 32 + 4 * fq;
        f32x4 gv[2][2], bv[2][2];
#pragma unroll
        for (int bj = 0; bj < 2; ++bj)
#pragma unroll
            for (int n = 0; n < 2; ++n) { gv[bj][n] = *(const f32x4*)(g + col0 + bj * HALF + n * 16); bv[bj][n] = *(const f32x4*)(b + col0 + bj * HALF + n * 16); }
#pragma unroll
        for (int ai = 0; ai < 2; ++ai)
#pragma unroll
            for (int m = 0; m < 4; ++m) { const int row = row0 + ai * HALF + m * 16; const float mean = stats[2 * row], rstd = stats[2 * row + 1];
                const float* xr = (row < M_P ? xp + (size_t)row * DM : xs + (size_t)(row - M_P) * DM) + col0; float* orow = out + (size_t)row * DM + col0;
#pragma unroll
                for (int bj = 0; bj < 2; ++bj)
#pragma unroll
                    for (int n = 0; n < 2; ++n) { const f32x4 x4 = *(const f32x4*)(xr + bj * HALF + n * 16); const f32x4 h = (x4 - mean) * rstd * gv[bj][n] + bv[bj][n];
                        *(f32x4*)(orow + bj * HALF + n * 16) = h * ALPHA + acc[ai][bj][m][n]; }
                if (m & 1) asm volatile("" ::: "memory"); }
    }
};

template <class Epi, class Sched, bool ALIGN_EPI = false, bool SP2 = false>
__device__ __forceinline__ void gemm_phase(PG8_LAS unsigned char* lds, const Gemm g, const Sched& S, const Epi& E) {
    const int tid = threadIdx.x, wid = __builtin_amdgcn_readfirstlane(tid >> 6), lane = tid & 63, wr = wid >> 2, wc = wid & 3, fr = lane & 15, fq = lane >> 4;
    const int K = g.K, nt = K / BK;
    unsigned voffA[2], voffB[2];
#pragma unroll
    for (int i = 0; i < 2; ++i) { int R, C; stage_rc(tid * 16 + i * 8192, R, C); const int Rb = Epi::PERM ? ((R & ~31) + perm32(R & 31)) : R;
        voffA[i] = (unsigned)(R * K + C) * 2u; voffB[i] = (unsigned)(Rb * K + C) * 2u; }
    const size_t kstep = (size_t)(BK * 2);
    const size_t hstep = (size_t)HALF * K * 2;
    const size_t tstep = 2 * hstep;
    const unsigned ldsw = (unsigned)wid * 1024u;
    const int aoff = lds_byte(wr * 64 + fr, fq * 8), boff = lds_byte(wc * 32 + fr, fq * 8);
#define PG8_SA(b, h) (((b) * 2 + (h)) * HTB)
#define PG8_SB(b, h) ((4 + (b) * 2 + (h)) * HTB)
#define PG8_STAGE(bufoff, gbase, voff) do { _Pragma("unroll") for (int _i = 0; _i < 2; ++_i) \
        __builtin_amdgcn_global_load_lds((const unsigned*)((const char*)(gbase) + (voff)[_i]), (PG8_LAS unsigned*)(lds + (bufoff) + ldsw + _i * 8192), 16, 0, 0); } while (0)
#define PG8_LDA(dst, b, h) do { _Pragma("unroll") for (int m = 0; m < 4; ++m) _Pragma("unroll") for (int k = 0; k < 2; ++k) dst[m][k] = *(const PG8_LAS bf16x8*)(lds + PG8_SA(b, h) + aoff + m * 2048 + k * 1024); } while (0)
#define PG8_LDB(dst, b, h) do { _Pragma("unroll") for (int n = 0; n < 2; ++n) _Pragma("unroll") for (int k = 0; k < 2; ++k) dst[n][k] = *(const PG8_LAS bf16x8*)(lds + PG8_SB(b, h) + boff + n * 2048 + k * 1024); } while (0)
#define PG8_MMA(ai, bj, At, Bt) do { __builtin_amdgcn_s_setprio(1); _Pragma("unroll") for (int m = 0; m < 4; ++m) _Pragma("unroll") for (int n = 0; n < 2; ++n) _Pragma("unroll") for (int k = 0; k < 2; ++k) \
        acc[ai][bj][m][n] = __builtin_amdgcn_mfma_f32_16x16x32_bf16(Bt[n][k], At[m][k], acc[ai][bj][m][n], 0, 0, 0); __builtin_amdgcn_s_setprio(0); } while (0)
#define PG8_WAIT_V(n) asm volatile("s_waitcnt vmcnt(" #n ")" ::: "memory")
#define PG8_WAIT_L(n) asm volatile("s_waitcnt lgkmcnt(" #n ")" ::: "memory")
#define PG8_BAR __builtin_amdgcn_s_barrier()
#define PG8_SCHED __builtin_amdgcn_sched_barrier(0)
    Unit cur, nxt; int ui = 0;
    if (!S.next(0, cur)) return;
    f32x4 acc[2][2][4][2];
#pragma unroll
    for (int a = 0; a < 2; ++a)
#pragma unroll
        for (int b = 0; b < 2; ++b)
#pragma unroll
            for (int m = 0; m < 4; ++m)
#pragma unroll
                for (int n = 0; n < 2; ++n) acc[a][b][m][n] = (f32x4){0.f, 0.f, 0.f, 0.f};
    bf16x8 At[4][2], B0[2][2], B1[2][2];
    const char* cA = (const char*)g.A + (size_t)cur.pm * tstep; const char* cB = (const char*)g.Bt + (size_t)cur.pn * tstep;
    S.a_ready(cur);
    if constexpr (SP2) {
        PG8_STAGE(PG8_SB(0, 0), cB, voffB); PG8_STAGE(PG8_SB(0, 1), cB + hstep, voffB); PG8_STAGE(PG8_SA(0, 0), cA, voffA); PG8_STAGE(PG8_SA(0, 1), cA + hstep, voffA);
        if (wr == 1) PG8_BAR;
        PG8_WAIT_V(2); PG8_BAR;
        PG8_STAGE(PG8_SB(1, 0), cB + kstep, voffB); PG8_STAGE(PG8_SA(1, 0), cA + kstep, voffA); PG8_STAGE(PG8_SB(1, 1), cB + hstep + kstep, voffB);
        PG8_WAIT_V(6); PG8_BAR;
    } else {
        PG8_STAGE(PG8_SB(0, 0), cB, voffB); PG8_STAGE(PG8_SA(0, 0), cA, voffA); PG8_STAGE(PG8_SB(0, 1), cB + hstep, voffB); PG8_STAGE(PG8_SA(0, 1), cA + hstep, voffA);
        if (wr == 1) PG8_BAR;
        PG8_WAIT_V(4); PG8_BAR;
        PG8_STAGE(PG8_SB(1, 0), cB + kstep, voffB); PG8_STAGE(PG8_SA(1, 0), cA + kstep, voffA); PG8_STAGE(PG8_SB(1, 1), cB + hstep + kstep, voffB);
        PG8_WAIT_V(6); PG8_BAR;
    }
    for (;;) {
        const bool has_next = S.next(ui + 1, nxt);
        const char* nA = has_next ? (const char*)g.A + (size_t)nxt.pm * tstep : cA; const char* nB = has_next ? (const char*)g.Bt + (size_t)nxt.pn * tstep : cB;
        for (int t = 0; t < nt; t += 2) {
            const bool last = (t == nt - 2);
            const char* a1 = cA + (size_t)(t + 1) * kstep;
            const char* a2 = last ? nA : cA + (size_t)(t + 2) * kstep; const char* b2 = last ? nB : cB + (size_t)(t + 2) * kstep;
            const char* a3 = a2 + kstep; const char* b3 = b2 + kstep;
            if (last && has_next) S.a_ready(nxt);
            if constexpr (SP2) {
            PG8_LDB(B0, 0, 0); PG8_LDB(B1, 0, 1); PG8_SCHED; PG8_LDA(At, 0, 0); PG8_STAGE(PG8_SA(1, 1), a1 + hstep, voffA);
            PG8_WAIT_V(8); PG8_WAIT_L(0); PG8_BAR; PG8_MMA(0, 0, At, B0); PG8_MMA(0, 1, At, B1); PG8_BAR; PG8_SCHED;
            PG8_LDA(At, 0, 1); PG8_STAGE(PG8_SB(0, 0), b2, voffB); PG8_STAGE(PG8_SB(0, 1), b2 + hstep, voffB); PG8_STAGE(PG8_SA(0, 0), a2, voffA);
            PG8_WAIT_V(8); PG8_WAIT_L(0); PG8_BAR; PG8_MMA(1, 0, At, B0); PG8_MMA(1, 1, At, B1); PG8_BAR; PG8_SCHED;
            PG8_LDB(B0, 1, 0); PG8_LDB(B1, 1, 1); PG8_SCHED; PG8_LDA(At, 1, 0); PG8_STAGE(PG8_SA(0, 1), a2 + hstep, voffA);
            PG8_WAIT_V(8); PG8_WAIT_L(0); PG8_BAR; PG8_MMA(0, 0, At, B0); PG8_MMA(0, 1, At, B1); PG8_BAR; PG8_SCHED;
            PG8_LDA(At, 1, 1); PG8_STAGE(PG8_SB(1, 0), b3, voffB); PG8_STAGE(PG8_SB(1, 1), b3 + hstep, voffB); PG8_STAGE(PG8_SA(1, 0), a3, voffA);
            PG8_WAIT_V(8); PG8_WAIT_L(0); PG8_BAR; PG8_MMA(1, 0, At, B0); PG8_MMA(1, 1, At, B1); PG8_BAR; PG8_SCHED;
            } else {
            PG8_LDB(B0, 0, 0); PG8_SCHED; PG8_LDA(At, 0, 0); PG8_STAGE(PG8_SA(1, 1), a1 + hstep, voffA);
            PG8_WAIT_L(8); PG8_BAR; PG8_WAIT_L(0); PG8_MMA(0, 0, At, B0); PG8_BAR; PG8_SCHED;
            PG8_LDB(B1, 0, 1); PG8_STAGE(PG8_SB(0, 0), b2, voffB);
            PG8_BAR; PG8_WAIT_L(0); PG8_MMA(0, 1, At, B1); PG8_BAR;
            PG8_LDA(At, 0, 1); PG8_STAGE(PG8_SA(0, 0), a2, voffA);
            PG8_BAR; PG8_WAIT_L(0); PG8_MMA(1, 0, At, B0); PG8_BAR; PG8_SCHED;
            PG8_STAGE(PG8_SB(0, 1), b2 + hstep, voffB);
            PG8_WAIT_V(6); PG8_BAR; PG8_MMA(1, 1, At, B1); PG8_BAR;
            PG8_LDB(B0, 1, 0); PG8_SCHED; PG8_LDA(At, 1, 0); PG8_STAGE(PG8_SA(0, 1), a2 + hstep, voffA);
            PG8_WAIT_L(8); PG8_BAR; PG8_WAIT_L(0); PG8_MMA(0, 0, At, B0); PG8_BAR; PG8_SCHED;
            PG8_LDB(B1, 1, 1); PG8_STAGE(PG8_SB(1, 0), b3, voffB);
            PG8_BAR; PG8_WAIT_L(0); PG8_MMA(0, 1, At, B1); PG8_BAR;
            PG8_LDA(At, 1, 1); PG8_STAGE(PG8_SA(1, 0), a3, voffA);
            PG8_BAR; PG8_WAIT_L(0); PG8_MMA(1, 0, At, B0); PG8_BAR; PG8_SCHED;
            PG8_STAGE(PG8_SB(1, 1), b3 + hstep, voffB);
            PG8_WAIT_V(6); PG8_BAR; PG8_MMA(1, 1, At, B1); PG8_BAR;
            }
        }
        if constexpr (ALIGN_EPI) { if (wr == 0) PG8_BAR; }
        if constexpr (!Epi::AFTER_DRAIN) { E(acc, cur, wr, wc, fr, fq); S.done(cur); }
        if (!has_next) break;
#pragma unroll
        for (int a = 0; a < 2; ++a)
#pragma unroll
            for (int b = 0; b < 2; ++b)
#pragma unroll
                for (int m = 0; m < 4; ++m)
#pragma unroll
                    for (int n = 0; n < 2; ++n) acc[a][b][m][n] = (f32x4){0.f, 0.f, 0.f, 0.f};
        cur = nxt; cA = nA; cB = nB; ++ui;
        if constexpr (ALIGN_EPI) { if (wr == 1) PG8_BAR; }
    }
    PG8_WAIT_V(0);
    if constexpr (!ALIGN_EPI) { if (wr == 0) PG8_BAR; }
    PG8_BAR;
    if constexpr (Epi::AFTER_DRAIN) { E.fused(acc, cur, wr, wc, fr, fq, lds, wid, lane); S.done(cur); }
#undef PG8_SA
#undef PG8_SB
#undef PG8_STAGE
#undef PG8_LDA
#undef PG8_LDB
#undef PG8_MMA
#undef PG8_WAIT_V
#undef PG8_WAIT_L
#undef PG8_BAR
#undef PG8_SCHED
}
}

template <int MODE>
__device__ __forceinline__ void gemm_simple(const Args& a, const bf16_t* A, const bf16_t* Bt, int Mr, int N, int K, bf16_t* Cb, int ldc, int gw, int ngw, int lane) {
    const int nT = N / 32, tiles = (Mr / 32) * nT, r32 = lane & 31, hi = lane >> 5;
    const float* rope = (const float*)(a.ws + WS_ROPE); const float* stats = (const float*)(a.ws + WS_STATS);
    for (int t = gw; t < tiles; t += ngw) {
        const int tm = t / nT, tn = t % nT;
        const bf16_t* ap = A + (size_t)(tm * 32 + r32) * K + hi * 8; const bf16_t* bp = Bt + (size_t)(tn * 32 + r32) * K + hi * 8;
        f32x16 acc = {};
#pragma unroll 4
        for (int k = 0; k < K; k += 16) { const bf16x8 af = *(const bf16x8*)(ap + k), bfr = *(const bf16x8*)(bp + k); acc = __builtin_amdgcn_mfma_f32_32x32x16_bf16(af, bfr, acc, 0, 0, 0); }
        const int col = tn * 32 + r32;
#pragma unroll
        for (int r = 0; r < 16; ++r) {
            const int row = tm * 32 + (r & 3) + 8 * (r >> 2) + 4 * hi; float v = acc[r];
            if (MODE == 0) {
                const float vp = __shfl_xor(v, 8);
                if (col < 1024) { const int d = col & 63; if (d < 16) { const int tpos = row & (SEQ - 1), i = d & 7; const float c = rope[tpos * 16 + i], s = rope[tpos * 16 + 8 + i]; v = (d < 8) ? v * c - vp * s : v * c + vp * s; } }
                if (col < 512 || (col >= C_QMX && col < C_GMX)) v *= C2;
                Cb[(size_t)row * ldc + col] = (bf16_t)f2bf(v);
            } else if (MODE == 1) {
                Cb[(size_t)row * ldc + col] = (bf16_t)f2bf(v);
            } else {
                const float x = xrow(a, row)[col]; const float h = (x - stats[2 * row]) * stats[2 * row + 1] * a.in_g[col] + a.in_b[col];
                a.out[(size_t)row * DM + col] = ALPHA * h + v;
            }
        }
    }
}

__device__ __forceinline__ float lam_value(const Args& a, int lane) {
    const float p1 = wave_sum(a.lq1[lane] * a.lk1[lane]), p2 = wave_sum(a.lq2[lane] * a.lk2[lane]);
    return __expf(p1) - __expf(p2) + LAM_INIT;
}
__device__ __forceinline__ void mix_simple(const Args& a, char* lds, int gw, int ngw, int wave, int lane) {
    const bf16_t* P = (const bf16_t*)(a.ws + WS_PROJ); const bf16_t* KV = (const bf16_t*)(a.ws + WS_KV); bf16_t* MIX = (bf16_t*)(a.ws + WS_MIX);
    float* aw = (float*)(lds + wave * 8192);
    float* qs = (float*)(lds + 65536 + wave * 512);
    const float lam = lam_value(a, lane);
    for (int it = gw; it < M * 4; it += ngw) {
        const int m = it >> 2, h = it & 3, b = m / SEQ;
        const bf16_t* qp = P + (size_t)m * INW + C_QDA + h * 128;
        qs[lane] = bf2f(qp[lane]); qs[64 + lane] = bf2f(qp[64 + lane]);
        __builtin_amdgcn_s_waitcnt(0xC07F); asm volatile("" ::: "memory");
        const bf16_t* kb = P + (size_t)(b * SEQ + lane) * INW + C_KDA + h * 128;
#pragma unroll 1
        for (int c = 0; c < 2; ++c) {
            float sc[32];
#pragma unroll
            for (int i = 0; i < 32; ++i) {
                const bf16x8* kp = (const bf16x8*)(kb + (size_t)(64 * i) * INW + c * 64); float s0 = 0.f;
#pragma unroll
                for (int ch = 0; ch < 8; ++ch) { const bf16x8 k0 = kp[ch];
#pragma unroll
                    for (int e = 0; e < 8; ++e) s0 += bf2f((unsigned short)k0[e]) * qs[c * 64 + ch * 8 + e]; }
                sc[i] = s0;
            }
            float m0 = sc[0];
#pragma unroll
            for (int i = 1; i < 32; ++i) m0 = fmaxf(m0, sc[i]);
            m0 = wave_max(m0); float l0 = 0.f;
#pragma unroll
            for (int i = 0; i < 32; ++i) { sc[i] = exp2f(sc[i] - m0); l0 += sc[i]; }
            l0 = (c == 0 ? 1.f : -lam) / wave_sum(l0);
#pragma unroll
            for (int i = 0; i < 32; ++i) { if (c == 0) aw[lane + 64 * i] = sc[i] * l0; else aw[lane + 64 * i] += sc[i] * l0; }
        }
        __builtin_amdgcn_s_waitcnt(0xC07F); asm volatile("" ::: "memory");
        const unsigned* vp = (const unsigned*)(P + (size_t)(b * SEQ) * INW + C_VDA + h * 128) + lane;
        float o0 = 0.f, o1 = 0.f;
#pragma unroll 8
        for (int j = 0; j < SEQ; ++j) { const unsigned w = vp[(size_t)j * (INW / 2)]; const float p = aw[j]; o0 += p * bflo(w); o1 += p * bfhi(w); }
        const float ss = wave_sum(o0 * o0 + o1 * o1); const float rms = 1.f / sqrtf(ss * (1.f / 128.f) + LN_EPS);
        const unsigned gw2 = *((const unsigned*)(P + (size_t)m * INW + C_GDA + h * 128) + lane);
        const float r0 = o0 * rms * a.subln[2 * lane] * (1.f - LAM_INIT) * silu(bflo(gw2)), r1 = o1 * rms * a.subln[2 * lane + 1] * (1.f - LAM_INIT) * silu(bfhi(gw2));
        *((unsigned*)(MIX + (size_t)m * DM + h * 128) + lane) = pk2(r0, r1);
        __builtin_amdgcn_s_waitcnt(0xC07F); asm volatile("" ::: "memory");
    }
    for (int it = gw; it < M * 4; it += ngw) {
        const int m = it >> 2, h = it & 3, b = m / SEQ;
        qs[lane] = bf2f(P[(size_t)m * INW + C_QMX + h * 64 + lane]);
        __builtin_amdgcn_s_waitcnt(0xC07F); asm volatile("" ::: "memory");
        float sc[4]; const bf16_t* kb = KV + (size_t)(b * NMEM + lane) * KVW + h * 64;
#pragma unroll
        for (int i = 0; i < 4; ++i) { const bf16x8* kp = (const bf16x8*)(kb + (size_t)(64 * i) * KVW); float s0 = 0.f;
#pragma unroll
            for (int ch = 0; ch < 8; ++ch) { const bf16x8 k0 = kp[ch];
#pragma unroll
                for (int e = 0; e < 8; ++e) s0 += bf2f((unsigned short)k0[e]) * qs[ch * 8 + e]; }
            sc[i] = s0; }
        float mx = wave_max(fmaxf(fmaxf(sc[0], sc[1]), fmaxf(sc[2], sc[3]))); float l = 0.f;
#pragma unroll
        for (int i = 0; i < 4; ++i) { sc[i] = exp2f(sc[i] - mx); l += sc[i]; }
        l = 1.f / wave_sum(l);
#pragma unroll
        for (int i = 0; i < 4; ++i) aw[lane + 64 * i] = sc[i] * l;
        __builtin_amdgcn_s_waitcnt(0xC07F); asm volatile("" ::: "memory");
        const bf16_t* vp = KV + (size_t)(b * NMEM) * KVW + 256 + h * 64 + lane; float o = 0.f;
#pragma unroll 8
        for (int j = 0; j < NMEM; ++j) o += aw[j] * bf2f(vp[(size_t)j * KVW]);
        const float g = bf2f(P[(size_t)m * INW + C_GMX + h * 64 + lane]);
        MIX[(size_t)m * DM + 768 + h * 64 + lane] = (bf16_t)f2bf(o * silu(g));
        __builtin_amdgcn_s_waitcnt(0xC07F); asm volatile("" ::: "memory");
    }
    for (int m = gw; m < M; m += ngw) {
        const int t = m & (SEQ - 1);
        const bf16_t* pr = P + (size_t)m * INW;
#pragma unroll
        for (int e = 0; e < 4; ++e) { const int ch = 4 * lane + e;
            float u[3];
#pragma unroll
            for (int k = 0; k < 3; ++k) { const int tt = t + k - 1; u[k] = (tt >= 0 && tt < SEQ) ? bf2f(pr[(ptrdiff_t)(k - 1) * INW + C_CCV + ch]) * bf2f(pr[(ptrdiff_t)(k - 1) * INW + C_HCV + ch]) : 0.f; }
            const float y = a.conv_w[ch] * u[0] + a.conv_w[256 + ch] * u[1] + a.conv_w[512 + ch] * u[2];
            MIX[(size_t)m * DM + 512 + ch] = (bf16_t)f2bf(bf2f(pr[C_BCV + ch]) * y * silu(bf2f(pr[C_GCV + ch]))); }
    }
}

namespace mx {
typedef short s16x4 __attribute__((ext_vector_type(4)));
constexpr int NW = 8, QBLK = 32, KVBLK = 64;
constexpr int SHM_V = 16384, SHM_K = 8192;
constexpr int L_V = 0, L_K = 2 * SHM_V, L_WS = L_K + 2 * SHM_K, L_STASH = L_WS + 2048, L_END = L_STASH + 65536;
constexpr float THR = 8.f;
#define MX_KSWZ(row, colB) ((row) * 128 + ((colB) ^ ((((row) >> 1) & 7) << 4)))
#define MX_SBAR() __builtin_amdgcn_sched_barrier(0)
__device__ __forceinline__ int crow(int r, int hi) { return (r & 3) + 8 * (r >> 2) + 4 * hi; }
__device__ __forceinline__ unsigned cvtpk(float lo, float hi) { unsigned r; asm volatile("v_cvt_pk_bf16_f32 %0, %1, %2" : "=v"(r) : "v"(lo), "v"(hi)); return r; }

__device__ __forceinline__ void partialSM(f32x16& p0, f32x16& p1, float& m_reg, float& alpha) {
    float pmax = p0[0];
#pragma unroll
    for (int r = 1; r < 16; ++r) pmax = fmaxf(pmax, p0[r]);
#pragma unroll
    for (int r = 0; r < 16; ++r) pmax = fmaxf(pmax, p1[r]);
    { auto rr = __builtin_amdgcn_permlane32_swap(__float_as_uint(pmax), __float_as_uint(pmax), false, false); pmax = fmaxf(__uint_as_float(rr[0]), __uint_as_float(rr[1])); }
    float mn;
    if (__builtin_expect(__all(pmax - m_reg <= THR), 1)) { mn = m_reg; alpha = 1.f; }
    else { mn = fmaxf(m_reg, pmax); alpha = __builtin_amdgcn_exp2f(m_reg - mn); m_reg = mn; }
#pragma unroll
    for (int r = 0; r < 16; ++r) { p0[r] -= mn; p1[r] -= mn; }
#pragma unroll
    for (int r = 0; r < 16; ++r) p0[r] = __builtin_amdgcn_exp2f(p0[r]);
}
__device__ __forceinline__ void finishSM(f32x16& p0, f32x16& p1, float alpha, float& l_reg, bf16x8& pa0, bf16x8& pa1, bf16x8& pa2, bf16x8& pa3) {
#pragma unroll
    for (int r = 0; r < 16; ++r) p1[r] = __builtin_amdgcn_exp2f(p1[r]);
    float ps = 0.f;
#pragma unroll
    for (int r = 0; r < 16; ++r) ps += p0[r];
#pragma unroll
    for (int r = 0; r < 16; ++r) ps += p1[r];
    { auto rr = __builtin_amdgcn_permlane32_swap(__float_as_uint(ps), __float_as_uint(ps), false, false); ps = __uint_as_float(rr[0]) + __uint_as_float(rr[1]); }
    l_reg = l_reg * alpha + ps;
#define MX_PK4(P, BASE, OUT) do { unsigned a0 = cvtpk(P[BASE + 0], P[BASE + 1]), a1 = cvtpk(P[BASE + 2], P[BASE + 3]);   \
    unsigned b0 = cvtpk(P[BASE + 4], P[BASE + 5]), b1 = cvtpk(P[BASE + 6], P[BASE + 7]);                              \
    auto r0 = __builtin_amdgcn_permlane32_swap(a0, b0, false, false); auto r1 = __builtin_amdgcn_permlane32_swap(a1, b1, false, false); \
    u32x4 w = {r0[0], r1[0], r0[1], r1[1]}; OUT = __builtin_bit_cast(bf16x8, w); } while (0)
    MX_PK4(p0, 0, pa0); MX_PK4(p0, 8, pa1); MX_PK4(p1, 0, pa2); MX_PK4(p1, 8, pa3);
#undef MX_PK4
}
__device__ __forceinline__ void qkt(f32x16& p0, f32x16& p1, const char* Ks, const bf16x8* qr, int r32, int hi) {
    p0 = f32x16{}; p1 = f32x16{};
#pragma unroll
    for (int d0 = 0; d0 < 4; ++d0) { const int cb = d0 * 32 + hi * 16;
        const bf16x8 b0 = *reinterpret_cast<const bf16x8*>(Ks + MX_KSWZ(r32, cb));
        const bf16x8 b1 = *reinterpret_cast<const bf16x8*>(Ks + MX_KSWZ(32 + r32, cb));
        p0 = __builtin_amdgcn_mfma_f32_32x32x16_bf16(b0, qr[d0], p0, 0, 0, 0);
        p1 = __builtin_amdgcn_mfma_f32_32x32x16_bf16(b1, qr[d0], p1, 0, 0, 0); }
}
template <int NCB> __device__ __forceinline__ int v_st(int k, int c) { const int kk = (k & ~0xC) | ((k & 4) << 1) | ((k & 8) >> 1); return ((kk >> 3) * NCB + (c >> 5)) * 512 + ((kk & 7) * 32 + (c & 31)) * 2; }
__device__ __forceinline__ int v_rd_base(int lane) { return ((lane & 3) << 3) | (((lane >> 2) & 3) << 6) | (((lane >> 4) & 1) << 5) | (((lane >> 5) & 1) << 8); }
template <int OFF> __device__ __forceinline__ s16x4 tr_read(int vb) { s16x4 r; asm volatile("ds_read_b64_tr_b16 %0, %1 offset:%2" : "=&v"(r) : "v"(vb), "i"(OFF) : "memory"); return r; }
template <int NCB, int D0> __device__ __forceinline__ void pv_one(f32x16& od, int vb, bf16x8 pa0, bf16x8 pa1, bf16x8 pa2, bf16x8 pa3) {
    constexpr int KS = 2 * NCB * 512, HF = NCB * 512, B = D0 * 512;
    const s16x4 l0 = tr_read<B + 0 * KS>(vb), h0 = tr_read<B + 0 * KS + HF>(vb), l1 = tr_read<B + 1 * KS>(vb), h1 = tr_read<B + 1 * KS + HF>(vb);
    const s16x4 l2 = tr_read<B + 2 * KS>(vb), h2 = tr_read<B + 2 * KS + HF>(vb), l3 = tr_read<B + 3 * KS>(vb), h3 = tr_read<B + 3 * KS + HF>(vb);
    asm volatile("s_waitcnt lgkmcnt(0)" ::: "memory"); MX_SBAR();
#define MX_PK(L, H) (bf16x8){L[0], L[1], L[2], L[3], H[0], H[1], H[2], H[3]}
    od = __builtin_amdgcn_mfma_f32_32x32x16_bf16(pa0, MX_PK(l0, h0), od, 0, 0, 0);
    od = __builtin_amdgcn_mfma_f32_32x32x16_bf16(pa1, MX_PK(l1, h1), od, 0, 0, 0);
    od = __builtin_amdgcn_mfma_f32_32x32x16_bf16(pa2, MX_PK(l2, h2), od, 0, 0, 0);
    od = __builtin_amdgcn_mfma_f32_32x32x16_bf16(pa3, MX_PK(l3, h3), od, 0, 0, 0);
#undef MX_PK
}
template <int NCB> __device__ __forceinline__ void pv_all(f32x16* o, int vb, bf16x8 pa0, bf16x8 pa1, bf16x8 pa2, bf16x8 pa3) {
    pv_one<NCB, 0>(o[0], vb, pa0, pa1, pa2, pa3); pv_one<NCB, 1>(o[1], vb, pa0, pa1, pa2, pa3);
    if constexpr (NCB == 4) { pv_one<NCB, 2>(o[2], vb, pa0, pa1, pa2, pa3); pv_one<NCB, 3>(o[3], vb, pa0, pa1, pa2, pa3); }
}

template <int DV, int LDQ, int LDK>
__device__ __forceinline__ void attn_pass(const bf16_t* __restrict__ Qw, const bf16_t* __restrict__ Kh, const bf16_t* __restrict__ Vh, int NT, char* lds, f32x16 (&o)[DV / 32], float& l_out) {
    constexpr int NCB = DV / 32;
    int tid = threadIdx.x; asm volatile("" : "+v"(tid));
    const int wid = tid >> 6, lane = tid & 63, r32 = lane & 31, hi = lane >> 5;
    char* V_lds = lds + L_V; char* K_lds = lds + L_K;
    float* ws = (float*)(lds + L_WS) + wid * 64; float* al_l = ws + 32;
    float m_reg = -1e30f, l_reg = 0.f; bf16x8 qr[4];
#pragma unroll
    for (int d = 0; d < NCB; ++d) o[d] = f32x16{};
    const bf16_t* Ql = Qw + (long)r32 * LDQ + hi * 8;
#pragma unroll
    for (int d0 = 0; d0 < 4; ++d0) qr[d0] = *reinterpret_cast<const bf16x8*>(Ql + d0 * 16);
    const int kr = tid >> 3, kc = (tid & 7) * 8, kst = MX_KSWZ(kr, kc * 2);
    const int sr = (DV == 128) ? (tid >> 4) : (tid >> 3), sc = (DV == 128) ? (tid & 15) * 8 : (tid & 7) * 8;
    const int vst0 = v_st<NCB>(sr, sc), vst1 = v_st<NCB>(32 + sr, sc);
    const int vb0 = (int)(uintptr_t)V_lds + v_rd_base(lane);
    bf16x8 sv0[2], sv1[2], sk[2];
#define MX_SLOAD(i, k0) do { sv0[i] = *reinterpret_cast<const bf16x8*>(&Vh[(long)((k0) + sr) * LDK + sc]); \
    if constexpr (DV == 128) sv1[i] = *reinterpret_cast<const bf16x8*>(&Vh[(long)((k0) + 32 + sr) * LDK + sc]); \
    sk[i] = *reinterpret_cast<const bf16x8*>(&Kh[(long)((k0) + kr) * LDK + kc]); } while (0)
#define MX_SWRITE(b, i) do { *(bf16x8*)(V_lds + (b) * SHM_V + vst0) = sv0[i]; if constexpr (DV == 128) *(bf16x8*)(V_lds + (b) * SHM_V + vst1) = sv1[i]; \
    *(bf16x8*)(K_lds + (b) * SHM_K + kst) = sk[i]; } while (0)
#define MX_SWAIT() do { if constexpr (DV == 128) asm volatile("s_waitcnt vmcnt(3)" ::: "memory"); else asm volatile("s_waitcnt vmcnt(2)" ::: "memory"); } while (0)
#define MX_RESC(a) do { if (__any((a) < 1.f)) { if (hi == 0) al_l[r32] = (a); asm volatile("s_waitcnt lgkmcnt(0)" ::: "memory"); \
    _Pragma("unroll") for (int d = 0; d < NCB; ++d) _Pragma("unroll") for (int r = 0; r < 16; ++r) o[d][r] *= al_l[crow(r, hi)]; } } while (0)
    f32x16 pA0, pA1, pB0, pB1; float alA, alB; bf16x8 pa0, pa1, pa2, pa3;
    MX_SLOAD(0, 0); asm volatile("s_waitcnt vmcnt(0)" ::: "memory"); MX_SWRITE(0, 0); __syncthreads();
    qkt(pA0, pA1, K_lds, qr, r32, hi); partialSM(pA0, pA1, m_reg, alA);
    MX_SLOAD(1, KVBLK); if (2 < NT) MX_SLOAD(0, 2 * KVBLK);
    MX_SWAIT(); MX_SWRITE(1, 1); __syncthreads();
    for (int j = 1; j + 1 < NT; j += 2) {
        MX_SBAR(); qkt(pB0, pB1, K_lds + SHM_K, qr, r32, hi);
        finishSM(pA0, pA1, alA, l_reg, pa0, pa1, pa2, pa3); MX_SBAR();
        MX_SLOAD(1, (j + 2) * KVBLK); MX_SBAR();
        pv_all<NCB>(o, vb0, pa0, pa1, pa2, pa3); partialSM(pB0, pB1, m_reg, alB);
        __syncthreads(); MX_SWAIT(); MX_SWRITE(0, 0);
        MX_RESC(alB); __syncthreads();
        MX_SBAR(); qkt(pA0, pA1, K_lds, qr, r32, hi);
        finishSM(pB0, pB1, alB, l_reg, pa0, pa1, pa2, pa3); MX_SBAR();
        if (j + 3 < NT) MX_SLOAD(0, (j + 3) * KVBLK); MX_SBAR();
        pv_all<NCB>(o, vb0 + SHM_V, pa0, pa1, pa2, pa3); partialSM(pA0, pA1, m_reg, alA);
        __syncthreads(); MX_SWAIT(); MX_SWRITE(1, 1);
        MX_RESC(alA); __syncthreads();
    }
    MX_SBAR(); qkt(pB0, pB1, K_lds + SHM_K, qr, r32, hi);
    finishSM(pA0, pA1, alA, l_reg, pa0, pa1, pa2, pa3); MX_SBAR();
    pv_all<NCB>(o, vb0, pa0, pa1, pa2, pa3); partialSM(pB0, pB1, m_reg, alB);
    __syncthreads(); MX_RESC(alB);
    finishSM(pB0, pB1, alB, l_reg, pa0, pa1, pa2, pa3); MX_SBAR();
    pv_all<NCB>(o, vb0 + SHM_V, pa0, pa1, pa2, pa3);
    l_out = l_reg;
#undef MX_SLOAD
#undef MX_SWRITE
#undef MX_SWAIT
#undef MX_RESC
}

__device__ __forceinline__ void mixer_phase(const Args& a, char* lds) {
    const int tid = threadIdx.x, wid = __builtin_amdgcn_readfirstlane(tid >> 6);
    const int G = gridDim.x, bx = blockIdx.x, vcu = (G % 8 == 0) ? (bx % 8) * (G / 8) + bx / 8 : bx;
    const bf16_t* P = (const bf16_t*)(a.ws + WS_PROJ); const bf16_t* KV = (const bf16_t*)(a.ws + WS_KV); bf16_t* MIX = (bf16_t*)(a.ws + WS_MIX);
    const float lam = __builtin_bit_cast(float, __builtin_amdgcn_readfirstlane(__builtin_bit_cast(int, lam_value(a, tid & 63))));
    float* li_l = (float*)(lds + L_WS) + wid * 64;
    unsigned* stash = (unsigned*)(lds + L_STASH + wid * 8192);
    bf16_t* stg = (bf16_t*)stash;
    for (int u = vcu; u < NSEQ * 4 * 8; u += G) {
        const int bh = u >> 3, qb = u & 7, b = bh >> 2, h = bh & 3;
        const long row0 = (long)b * SEQ + qb * 256;
        const long wrow0 = row0 + wid * 32;
#pragma unroll 1
        for (int c = 0; c < 2; ++c) {
            f32x16 o[4]; float l_reg;
            attn_pass<128, INW, INW>(P + wrow0 * INW + C_QDA + h * 128 + c * 64, P + (long)b * SEQ * INW + C_KDA + h * 128 + c * 64, P + (long)b * SEQ * INW + C_VDA + h * 128, SEQ / KVBLK, lds, o, l_reg);
            int lane = threadIdx.x & 63; asm volatile("" : "+v"(lane));
            const int r32 = lane & 31, hi = lane >> 5, erow = lane >> 1, ehalf = lane & 1;
            if (hi == 0) li_l[r32] = l_reg;
            asm volatile("s_waitcnt lgkmcnt(0)" ::: "memory");
            float rli[16];
#pragma unroll
            for (int r = 0; r < 16; ++r) rli[r] = __builtin_amdgcn_rcpf(li_l[crow(r, hi)]);
            if (c == 0) {
#pragma unroll
                for (int d0 = 0; d0 < 4; ++d0)
#pragma unroll
                    for (int r2 = 0; r2 < 8; ++r2) stash[(d0 * 8 + r2) * 64 + lane] = cvtpk(o[d0][2 * r2] * rli[2 * r2], o[d0][2 * r2 + 1] * rli[2 * r2 + 1]);
            } else {
#pragma unroll
                for (int d0 = 0; d0 < 4; ++d0)
#pragma unroll
                    for (int r2 = 0; r2 < 8; ++r2) { const unsigned w = stash[(d0 * 8 + r2) * 64 + lane];
                        o[d0][2 * r2] = bflo(w) - lam * (o[d0][2 * r2] * rli[2 * r2]); o[d0][2 * r2 + 1] = bfhi(w) - lam * (o[d0][2 * r2 + 1] * rli[2 * r2 + 1]); }
                asm volatile("s_waitcnt lgkmcnt(0)" ::: "memory");
#pragma unroll
                for (int d0 = 0; d0 < 4; ++d0)
#pragma unroll
                    for (int r = 0; r < 16; ++r) stg[crow(r, hi) * 128 + d0 * 32 + r32] = (bf16_t)f2bf(o[d0][r]);
                asm volatile("s_waitcnt lgkmcnt(0)" ::: "memory");
                u32x4 dv[8]; float ss = 0.f;
#pragma unroll
                for (int ch = 0; ch < 8; ++ch) { dv[ch] = *(const u32x4*)(stg + erow * 128 + ehalf * 64 + ch * 8);
#pragma unroll
                    for (int e = 0; e < 4; ++e) { const float x0 = bflo(dv[ch][e]), x1 = bfhi(dv[ch][e]); ss += x0 * x0 + x1 * x1; } }
                ss += __shfl_xor(ss, 1);
                const float rms = (1.f - LAM_INIT) / sqrtf(ss * (1.f / 128.f) + LN_EPS);
                const long m = wrow0 + erow;
                const bf16_t* gp = P + m * INW + C_GDA + h * 128 + ehalf * 64; bf16_t* op = MIX + m * DM + h * 128 + ehalf * 64; const float* sg = a.subln + ehalf * 64;
#pragma unroll
                for (int ch = 0; ch < 8; ++ch) { const u32x4 g8 = *(const u32x4*)(gp + ch * 8); const f32x4 s0 = *(const f32x4*)(sg + ch * 8), s1 = *(const f32x4*)(sg + ch * 8 + 4); u32x4 w;
#pragma unroll
                    for (int e = 0; e < 4; ++e) { const float sa = e < 2 ? s0[2 * e] : s1[2 * e - 4], sb = e < 2 ? s0[2 * e + 1] : s1[2 * e - 3];
                        w[e] = cvtpk(bflo(dv[ch][e]) * rms * sa * silu(bflo(g8[e])), bfhi(dv[ch][e]) * rms * sb * silu(bfhi(g8[e]))); }
                    *(u32x4*)(op + ch * 8) = w; }
            }
            asm volatile("s_waitcnt lgkmcnt(0)" ::: "memory");
        }
        {
            f32x16 o[2]; float l_reg;
            attn_pass<64, INW, KVW>(P + wrow0 * INW + C_QMX + h * 64, KV + (long)b * NMEM * KVW + h * 64, KV + (long)b * NMEM * KVW + 256 + h * 64, NMEM / KVBLK, lds, o, l_reg);
            int lane = threadIdx.x & 63; asm volatile("" : "+v"(lane));
            const int r32 = lane & 31, hi = lane >> 5, erow = lane >> 1, ehalf = lane & 1;
            if (hi == 0) li_l[r32] = l_reg;
            asm volatile("s_waitcnt lgkmcnt(0)" ::: "memory");
#pragma unroll
            for (int r = 0; r < 16; ++r) { const float rl = __builtin_amdgcn_rcpf(li_l[crow(r, hi)]);
#pragma unroll
                for (int d0 = 0; d0 < 2; ++d0) stg[crow(r, hi) * 64 + d0 * 32 + r32] = (bf16_t)f2bf(o[d0][r] * rl); }
            asm volatile("s_waitcnt lgkmcnt(0)" ::: "memory");
            const long m = wrow0 + erow;
            const bf16_t* gp = P + m * INW + C_GMX + h * 64 + ehalf * 32; bf16_t* op = MIX + m * DM + 768 + h * 64 + ehalf * 32;
#pragma unroll
            for (int ch = 0; ch < 4; ++ch) { const u32x4 d8 = *(const u32x4*)(stg + erow * 64 + ehalf * 32 + ch * 8); const u32x4 g8 = *(const u32x4*)(gp + ch * 8); u32x4 w;
#pragma unroll
                for (int e = 0; e < 4; ++e) w[e] = cvtpk(bflo(d8[e]) * silu(bflo(g8[e])), bfhi(d8[e]) * silu(bfhi(g8[e])));
                *(u32x4*)(op + ch * 8) = w; }
            asm volatile("s_waitcnt lgkmcnt(0)" ::: "memory");
        }
        {
            int tid2 = threadIdx.x; asm volatile("" : "+v"(tid2));
            const int crow_ = tid2 >> 1, t = qb * 256 + crow_, chb = h * 64 + (tid2 & 1) * 32;
            const bf16_t* pr = P + (row0 + crow_) * INW; bf16_t* op = MIX + (row0 + crow_) * DM + 512 + chb;
            const bool hasm = t > 0, hasp = t < SEQ - 1;
#pragma unroll 1
            for (int ch = 0; ch < 4; ++ch) { const int cc = chb + ch * 8; const u32x4 z = {0u, 0u, 0u, 0u};
                const u32x4 c0 = *(const u32x4*)(pr + C_CCV + cc), h0 = *(const u32x4*)(pr + C_HCV + cc), b0 = *(const u32x4*)(pr + C_BCV + cc), g0 = *(const u32x4*)(pr + C_GCV + cc);
                const u32x4 cm = hasm ? *(const u32x4*)(pr - INW + C_CCV + cc) : z, hm = hasm ? *(const u32x4*)(pr - INW + C_HCV + cc) : z;
                const u32x4 cp = hasp ? *(const u32x4*)(pr + INW + C_CCV + cc) : z, hp = hasp ? *(const u32x4*)(pr + INW + C_HCV + cc) : z;
                float w0[8], w1[8], w2[8];
#pragma unroll
                for (int q = 0; q < 2; ++q) { const f32x4 x0 = *(const f32x4*)(a.conv_w + cc + 4 * q), x1 = *(const f32x4*)(a.conv_w + 256 + cc + 4 * q), x2 = *(const f32x4*)(a.conv_w + 512 + cc + 4 * q);
#pragma unroll
                    for (int e = 0; e < 4; ++e) { w0[4 * q + e] = x0[e]; w1[4 * q + e] = x1[e]; w2[4 * q + e] = x2[e]; } }
                u32x4 w;
#pragma unroll
                for (int e = 0; e < 4; ++e) {
                    const float ya = w0[2 * e] * (bflo(cm[e]) * bflo(hm[e])) + w1[2 * e] * (bflo(c0[e]) * bflo(h0[e])) + w2[2 * e] * (bflo(cp[e]) * bflo(hp[e]));
                    const float yb = w0[2 * e + 1] * (bfhi(cm[e]) * bfhi(hm[e])) + w1[2 * e + 1] * (bfhi(c0[e]) * bfhi(h0[e])) + w2[2 * e + 1] * (bfhi(cp[e]) * bfhi(hp[e]));
                    w[e] = cvtpk(bflo(b0[e]) * ya * silu(bflo(g0[e])), bfhi(b0[e]) * yb * silu(bfhi(g0[e]))); }
                *(u32x4*)(op + ch * 8) = w; }
        }
    }
}
#undef MX_KSWZ
#undef MX_SBAR
}

__device__ __forceinline__ void final_ln(const Args& a, int gw, int ngw, int lane) {
    f32x4 g4[4], b4[4];
#pragma unroll
    for (int j = 0; j < 4; ++j) { g4[j] = ((const f32x4*)a.ln_g)[64 * j + lane]; b4[j] = ((const f32x4*)a.ln_b)[64 * j + lane]; }
    for (int m = gw; m < M; m += ngw) {
        f32x4* xr = (f32x4*)(a.out + (size_t)m * DM) + lane;
        f32x4 v[4]; float s = 0.f;
#pragma unroll
        for (int j = 0; j < 4; ++j) { v[j] = xr[64 * j]; s += (v[j].x + v[j].y) + (v[j].z + v[j].w); }
        const float mean = wave_sum(s) * (1.f / DM); float s2 = 0.f;
#pragma unroll
        for (int j = 0; j < 4; ++j) { v[j] = v[j] - mean; s2 += (v[j].x * v[j].x + v[j].y * v[j].y) + (v[j].z * v[j].z + v[j].w * v[j].w); }
        const float rstd = 1.f / sqrtf(wave_sum(s2) * (1.f / DM) + LN_EPS);
#pragma unroll
        for (int j = 0; j < 4; ++j) xr[64 * j] = v[j] * rstd * g4[j] + b4[j];
    }
}

constexpr int NWAVES = 8, NTHREADS = NWAVES * 64;
constexpr int LDS_BYTES = 147456;

__global__ void __launch_bounds__(NTHREADS, 2) fwd_megakernel(Args a) {
    extern __shared__ __attribute__((aligned(16))) char lds[];
    cg::grid_group grid = cg::this_grid();
    const int tid = threadIdx.x, lane = tid & 63, wave = __builtin_amdgcn_readfirstlane(tid >> 6);
    const int gw = blockIdx.x * NWAVES + wave, ngw = gridDim.x * NWAVES;
    unsigned char* ws = a.ws;
    stage0(a, lds, gw, ngw, wave, lane);
    grid.sync();
    {
        pg8::Gemm g{(const bf16_t*)(ws + WS_XN), (const bf16_t*)(ws + WS_WIN), M, INW, DM}; pg8::StaticOrder S; S.init(M, INW, (int)gridDim.x, (int)blockIdx.x);
        pg8::EpiProj E{(bf16_t*)(ws + WS_PROJ), (const float*)(ws + WS_ROPE)};
        pg8::gemm_phase<pg8::EpiProj, pg8::StaticOrder, true, true>((PG8_LAS unsigned char*)lds, g, S, E);
    }
    {
        pg8::Gemm g{(const bf16_t*)(ws + WS_MEMB), (const bf16_t*)(ws + WS_WKV), MM, KVW, DM}; pg8::StaticOrder S; S.init(MM, KVW, (int)gridDim.x, (int)blockIdx.x);
        pg8::EpiPlain E{(bf16_t*)(ws + WS_KV), KVW};
        pg8::gemm_phase<pg8::EpiPlain, pg8::StaticOrder, true, true>((PG8_LAS unsigned char*)lds, g, S, E);
    }
    grid.sync();
    mx::mixer_phase(a, lds);
    grid.sync();
    {
        pg8::Gemm g{(const bf16_t*)(ws + WS_MIX), (const bf16_t*)(ws + WS_WO), M, DM, DM}; pg8::StaticOrder S; S.init(M, DM, (int)gridDim.x, (int)blockIdx.x);
        pg8::EpiOut E{a.x_p, a.x_s, (const float*)(ws + WS_STATS), a.in_g, a.in_b, a.out};
        pg8::gemm_phase<pg8::EpiOut, pg8::StaticOrder, true, true>((PG8_LAS unsigned char*)lds, g, S, E);
    }
    grid.sync();
    final_ln(a, gw, ngw, lane);
}

extern "C" void kernel_launch(void* const* d_in, const int* in_sizes, int n_in, void* d_out, int out_size, void* d_ws, size_t ws_size, hipStream_t stream) {
    static int grid_blocks = 0;
    if (grid_blocks == 0) {
        if (n_in != 17 || in_sizes[0] != M_P * DM || in_sizes[1] != (M - M_P) * DM || out_size != M * DM || ws_size < WS_END) {
            fprintf(stderr, "kernel_launch: shape mismatch n_in %d in0 %d in1 %d out %d ws %zu\n", n_in, n_in > 0 ? in_sizes[0] : -1, n_in > 1 ? in_sizes[1] : -1, out_size, ws_size); grid_blocks = -1; return; }
        int dev = 0, cus = 0, per_cu = 0;
        hipGetDevice(&dev);
        hipDeviceGetAttribute(&cus, hipDeviceAttributeMultiprocessorCount, dev);
        hipFuncSetAttribute((const void*)fwd_megakernel, hipFuncAttributeMaxDynamicSharedMemorySize, LDS_BYTES);
        hipOccupancyMaxActiveBlocksPerMultiprocessor(&per_cu, (const void*)fwd_megakernel, NTHREADS, LDS_BYTES);
        if (per_cu < 1) { fprintf(stderr, "kernel_launch: occupancy query says %d blocks per CU\n", per_cu); per_cu = 1; }
        grid_blocks = cus * 1;
        (void)hipGetLastError();
    }
    if (grid_blocks < 0) return;
    Args a{};
    a.x_p = (const float*)d_in[0]; a.x_s = (const float*)d_in[1]; a.mem_p = (const float*)d_in[2]; a.mem_s = (const float*)d_in[3];
    a.in_g = (const float*)d_in[4]; a.in_b = (const float*)d_in[5]; a.w_in = (const float*)d_in[6]; a.w_kv = (const float*)d_in[7];
    a.lq1 = (const float*)d_in[8]; a.lk1 = (const float*)d_in[9]; a.lq2 = (const float*)d_in[10]; a.lk2 = (const float*)d_in[11];
    a.subln = (const float*)d_in[12]; a.conv_w = (const float*)d_in[13]; a.w_o = (const float*)d_in[14]; a.ln_g = (const float*)d_in[15]; a.ln_b = (const float*)d_in[16];
    a.out = (float*)d_out; a.ws = (unsigned char*)d_ws;
    void* args[] = {&a};
    hipError_t e = hipLaunchCooperativeKernel((const void*)fwd_megakernel, dim3(grid_blocks), dim3(NTHREADS), args, LDS_BYTES, stream);
    if (e != hipSuccess) fprintf(stderr, "kernel_launch: cooperative launch failed: %s (grid %d)\n", hipGetErrorString(e), grid_blocks);
}
```
